# Optimizing an MI355X kernel written in HIP

```python
import jax, jax.numpy as jnp
from jax import lax
import numpy as np

D_MODEL = 1024
BATCH = 4
SEQ = 8192
DEPTH = 2

GRID_W = 64
CTX_LEN = 256
D_MIX = 2 * D_MODEL
EPS = 1e-6

M_HEADS = 8
M_DV = D_MODEL // 8
M_DQK = M_DV // 2
M_WIDTH = M_HEADS * M_DV
QK_W = M_HEADS * M_DQK
M_CHUNK = 128
N_GATES = 4 * M_HEADS

S_WIDTH = D_MODEL // 2
S_GROUPS = 4
S_GC = S_WIDTH // S_GROUPS
S_CHUNK = 128
ROWS_PER_CHUNK = S_CHUNK // GRID_W

F_WIDTH = D_MODEL // 2
F_GROUPS = 4
F_GC = F_WIDTH // F_GROUPS

A_SPLITS = (QK_W, QK_W, M_WIDTH, N_GATES)
REST_SPLITS = (M_WIDTH, M_WIDTH, S_WIDTH, S_WIDTH, S_WIDTH, F_WIDTH, F_WIDTH)
A_IN = int(sum(A_SPLITS))
P_IN = A_IN + int(sum(REST_SPLITS))
A_SPLIT_IDX = tuple(int(i) for i in np.cumsum(A_SPLITS)[:-1])
REST_SPLIT_IDX = tuple(int(i) for i in np.cumsum(REST_SPLITS)[:-1])

kernel_name = 'hybrid_mlstm_sgu_fourier_dit_block'


def rms_norm(x, g):
    xf = x.astype(jnp.float32)
    y = xf * lax.rsqrt(jnp.mean(xf * xf, axis=-1, keepdims=True) + EPS)
    return (y * g.astype(jnp.float32)).astype(x.dtype)


def zero_state(bsz):
    return (jnp.zeros((bsz, M_HEADS, M_DQK, M_DV), jnp.float32),
            jnp.zeros((bsz, M_HEADS, M_DQK), jnp.float32),
            jnp.zeros((bsz, M_HEADS), jnp.float32))


def mlstm_scan(q, k, v, ig, lf, state):
    bsz, nh, t = ig.shape
    nc = t // M_CHUNK

    def chunks(a):
        return jnp.moveaxis(a.reshape(bsz, nh, nc, M_CHUNK, *a.shape[3:]), 2, 0)

    lower = jnp.tril(jnp.ones((M_CHUNK, M_CHUNK), dtype=bool))

    def step(carry, inp):
        C, n, m = carry
        qc, kc, vc, igc, lfc = inp
        b = jnp.cumsum(lfc, axis=-1)
        d_log = jnp.where(lower, b[..., :, None] - b[..., None, :] + igc[..., None, :], -jnp.inf)
        inter = b + m[..., None]
        m_t = jnp.maximum(inter, jnp.max(d_log, axis=-1))
        s = jnp.einsum('bhtk,bhsk->bhts', qc, kc) * jnp.exp(d_log - m_t[..., None])
        w_inter = jnp.exp(inter - m_t)
        num = jnp.einsum('bhts,bhsv->bhtv', s, vc) + w_inter[..., None] * jnp.einsum('bhtk,bhkv->bhtv', qc, C)
        den = jnp.sum(s, axis=-1) + w_inter * jnp.einsum('bhtk,bhk->bht', qc, n)
        hc = num / jnp.maximum(jnp.abs(den), jnp.exp(-m_t))[..., None]
        b_last = b[..., -1]
        w_log = b_last[..., None] - b + igc
        m_new = jnp.maximum(b_last + m, jnp.max(w_log, axis=-1))
        decay = jnp.exp(b_last + m - m_new)
        w_s = jnp.exp(w_log - m_new[..., None])
        C_new = decay[..., None, None] * C + jnp.einsum('bhs,bhsk,bhsv->bhkv', w_s, kc, vc)
        n_new = decay[..., None] * n + jnp.einsum('bhs,bhsk->bhk', w_s, kc)
        return (C_new, n_new, m_new), hc

    state, h = lax.scan(step, state, (chunks(q), chunks(k), chunks(v), chunks(ig), chunks(lf)))
    h = jnp.moveaxis(h, 0, 2).reshape(bsz, nh, t, M_DV)
    return h, state


def mlstm_from_proj(pa, b_gate, g_hnorm, init):
    bsz, t = pa.shape[:2]
    q, k, v, gates = jnp.split(pa, A_SPLIT_IDX, axis=-1)

    def heads(a, d):
        return a.astype(jnp.float32).reshape(bsz, t, M_HEADS, d).transpose(0, 2, 1, 3)

    qh = heads(q, M_DQK) * (M_DQK ** -0.5)
    kh = heads(k, M_DQK)
    vh = heads(v, M_DV)
    g = (gates.astype(jnp.float32) + b_gate.astype(jnp.float32)).reshape(bsz, t, 4, M_HEADS).transpose(2, 0, 3, 1)
    ig_f, lf_f = g[0], jax.nn.log_sigmoid(g[1])
    ig_b, lf_b = g[2], jax.nn.log_sigmoid(g[3])
    init_f, init_b = init
    h_f, st_f = mlstm_scan(qh, kh, vh, ig_f, lf_f, init_f)

    def rev(a):
        return jnp.flip(a, axis=2)

    h_b, st_b = mlstm_scan(rev(qh), rev(kh), rev(vh), rev(ig_b), rev(lf_b), init_b)
    h = h_f + rev(h_b)
    h = h * lax.rsqrt(jnp.mean(h * h, axis=-1, keepdims=True) + EPS)
    h = h * g_hnorm.astype(jnp.float32).reshape(M_HEADS, 1, M_DV)
    return h.transpose(0, 2, 1, 3).reshape(bsz, t, M_WIDTH), (st_f, st_b)


def spatial_gating(u, vs, g_sgu, w_sp, b_sp, n_chunks):
    bsz, t = u.shape[:2]
    vn = rms_norm(vs, g_sgu).reshape(bsz, n_chunks, S_CHUNK, S_GROUPS, S_GC)
    mixed = jnp.einsum('gts,bnsgc->bntgc', w_sp, vn) + b_sp.T[:, :, None]
    return u * mixed.reshape(bsz, t, S_WIDTH)


def fourier_mix(f, w_fno, b_fno):
    bsz, t = f.shape[:2]
    fg = f.astype(jnp.float32).reshape(bsz, t, F_GROUPS, F_GC)
    y = jnp.real(jnp.fft.fft2(fg, axes=(1, 3), norm='ortho'))
    y = jnp.einsum('btgc,gcd->btgd', y, w_fno.astype(jnp.float32)) + b_fno.astype(jnp.float32)
    return y.reshape(bsz, t, F_WIDTH).astype(f.dtype)


def mixer(h, n_chunks, init, w_in, b_gate, g_hnorm, g_sgu, w_sp, b_sp, w_fno, b_fno, w_out):
    p = h @ w_in
    h_a, states = mlstm_from_proj(p[..., :A_IN], b_gate, g_hnorm, init)
    o, z_a, u, vs, z_b, f, z_c = jnp.split(p[..., A_IN:], REST_SPLIT_IDX, axis=-1)
    y_a = h_a.astype(h.dtype) * jax.nn.sigmoid(o) * jax.nn.silu(z_a)
    y_b = spatial_gating(u, vs, g_sgu, w_sp, b_sp, n_chunks) * jax.nn.silu(z_b)
    y_c = fourier_mix(f, w_fno, b_fno) * jax.nn.silu(z_c)
    return jnp.concatenate([y_a, y_b, y_c], axis=-1) @ w_out, states


def setup_inputs(seed: int = 0) -> dict:
    key = jax.random.key(seed)
    ks = jax.random.split(key, 20)

    def nrm(k, shape, s):
        return jax.random.normal(k, shape, jnp.float32) * s

    x = nrm(ks[0], (BATCH, SEQ, D_MODEL), 1.0)
    c = nrm(ks[1], (BATCH, D_MODEL), 1.0)
    ctx = nrm(ks[2], (BATCH, CTX_LEN, D_MODEL), 1.0)
    c_ctx = nrm(ks[3], (D_MODEL,), 1.0)
    w_mod = nrm(ks[4], (DEPTH, D_MODEL, 3 * D_MODEL), 0.5 * D_MODEL ** -0.5)
    b_mod = nrm(ks[5], (DEPTH, 3 * D_MODEL), 0.01)
    g_pre = 1.0 + nrm(ks[6], (DEPTH, D_MODEL), 0.01)
    g_post = 1.0 + nrm(ks[7], (DEPTH, D_MODEL), 0.01)
    w_in = nrm(ks[8], (DEPTH, D_MODEL, P_IN), D_MODEL ** -0.5)
    ig_bias = nrm(ks[9], (DEPTH, 2, M_HEADS), 0.1)
    fg_bias = jnp.linspace(3.0, 6.0, M_HEADS) + nrm(ks[10], (DEPTH, 2, M_HEADS), 0.1)
    b_gate = jnp.stack([ig_bias, fg_bias], axis=2).reshape(DEPTH, N_GATES)
    g_hnorm = 1.0 + nrm(ks[11], (DEPTH, M_WIDTH), 0.01)
    g_sgu = 1.0 + nrm(ks[12], (DEPTH, S_WIDTH), 0.01)
    w_sp = nrm(ks[13], (DEPTH, S_GROUPS, S_CHUNK, S_CHUNK), S_CHUNK ** -0.5)
    b_sp = 1.0 + nrm(ks[14], (DEPTH, S_GROUPS, S_CHUNK), 0.01)
    w_fno = nrm(ks[15], (DEPTH, F_GROUPS, F_GC, F_GC), F_GC ** -0.5)
    b_fno = nrm(ks[16], (DEPTH, F_GROUPS, F_GC), 0.01)
    w_out = nrm(ks[17], (DEPTH, D_MIX, D_MODEL), D_MIX ** -0.5)
    return {'x': x, 'c': c, 'ctx': ctx, 'c_ctx': c_ctx, 'w_mod': w_mod, 'b_mod': b_mod,
            'g_pre': g_pre, 'g_post': g_post, 'w_in': w_in, 'b_gate': b_gate, 'g_hnorm': g_hnorm,
            'g_sgu': g_sgu, 'w_sp': w_sp, 'b_sp': b_sp, 'w_fno': w_fno, 'b_fno': b_fno, 'w_out': w_out}


def reference(x, c, ctx, c_ctx, w_mod, b_mod, g_pre, g_post, w_in, b_gate, g_hnorm,
              g_sgu, w_sp, b_sp, w_fno, b_fno, w_out):
    bsz = x.shape[0]
    rows = x.shape[1] // GRID_W
    lat_chunks = rows // ROWS_PER_CHUNK
    ctx_chunks = ctx.shape[1] // S_CHUNK
    xc = ctx
    for l in range(DEPTH):
        mod_lat = jax.nn.silu(c) @ w_mod[l] + b_mod[l]
        mod_ctx = jax.nn.silu(c_ctx) @ w_mod[l] + b_mod[l]
        sh_l, sc_l, gt_l = jnp.split(mod_lat, 3, axis=-1)
        sh_c, sc_c, gt_c = jnp.split(mod_ctx, 3, axis=-1)
        params = (w_in[l], b_gate[l], g_hnorm[l], g_sgu[l], w_sp[l], b_sp[l], w_fno[l], b_fno[l], w_out[l])
        hc = rms_norm(xc, g_pre[l]) * (1.0 + sc_c) + sh_c
        init0 = (zero_state(bsz), zero_state(bsz))
        if l < DEPTH - 1:
            yc, ctx_states = mixer(hc, ctx_chunks, init0, *params)
        else:
            _, ctx_states = mlstm_from_proj(hc @ w_in[l][:, :A_IN], b_gate[l], g_hnorm[l], init0)
        h = rms_norm(x, g_pre[l]) * (1.0 + sc_l[:, None, :]) + sh_l[:, None, :]
        y, _ = mixer(h, lat_chunks, ctx_states, *params)
        x = x + gt_l[:, None, :] * rms_norm(y, g_post[l])
        if l < DEPTH - 1:
            xc = xc + gt_c * rms_norm(yc, g_post[l])
    return x
```

```cpp
#include <hip/hip_runtime.h>
#include <hip/hip_cooperative_groups.h>
#include <cstdio>
namespace cg = cooperative_groups;

typedef unsigned short bf;
typedef __attribute__((ext_vector_type(8))) short bf16x8;
typedef __attribute__((ext_vector_type(16))) float f32x16;

#define DEV __device__ __forceinline__

constexpr int D = 1024, TB = 8448, ROWS = 33792, HROWS = 16896;
constexpr int NP = 7200, NPW = 7296, NIN = 6688;
constexpr int CQ = 0, CK = 512, CV = 1024, CO = 2048, CZA = 3072, CU = 4096, CVS = 4608, CZB = 5120,
              CHR = 5632, CZC = 6144, CHI = 6656, CG = 7168;
constexpr int SRC_G = 2048, SRC_F = 5664;
constexpr int SSLOT = 8256;
constexpr float EPS = 1e-6f;
constexpr int BKP = 40;
constexpr int LDS_BYTES = 80896;
constexpr int OFF_SB = 36864, OFF_SB32 = 20480, OFF_SL = 40960, OFF_VEC = 75776;

struct Params {
  const float *x, *c, *ctx, *c_ctx, *w_mod, *b_mod, *g_pre, *g_post, *w_in, *b_gate, *g_hnorm, *g_sgu, *w_sp, *b_sp,
      *w_fno, *b_fno, *w_out;
  float* out;
  bf *wt_in, *wt_out, *wsp, *m1, *m2, *mctx, *hN, *P, *abuf, *ybuf, *cbuf, *states;
  float *mod, *tw, *Q, *gates, *nbuf, *scal, *mstart, *xc1;
  unsigned* bar;
};

typedef __attribute__((ext_vector_type(2))) __bf16 bf16x2_t;
typedef __attribute__((ext_vector_type(2))) float f32x2_t;
DEV unsigned pack2(float a, float b) {
  f32x2_t f = {a, b};
  bf16x2_t h = __builtin_convertvector(f, bf16x2_t);
  return __builtin_bit_cast(unsigned, h);
}
DEV bf f2bf(float f) { return (bf)(pack2(f, f) & 0xffffu); }
DEV float bf2f(bf h) { return __uint_as_float(((unsigned)h) << 16); }
DEV float lo2f(unsigned u) { return __uint_as_float(u << 16); }
DEV float hi2f(unsigned u) { return __uint_as_float(u & 0xffff0000u); }
DEV int otid() {
  int t = threadIdx.x;
  asm volatile("" : "+v"(t));
  return t;
}
DEV int obid() {
  int b = blockIdx.x;
  asm volatile("" : "+s"(b));
  return b;
}
DEV unsigned pidx(int row, int col) { return (unsigned)(((col >> 7) * HROWS + row) * 128 + (col & 127)); }
typedef __attribute__((ext_vector_type(4))) float f32x4v;
DEV float4 nt_load4(const float* p) {
  f32x4v v = __builtin_nontemporal_load((const f32x4v*)p);
  return make_float4(v[0], v[1], v[2], v[3]);
}
DEV void nt_store4(float* p, float4 o) {
  f32x4v v = {o.x, o.y, o.z, o.w};
  __builtin_nontemporal_store(v, (f32x4v*)p);
}
typedef __attribute__((ext_vector_type(4))) unsigned u32x4nt;
DEV uint4 nt_load16(const void* p) {
  u32x4nt v = __builtin_nontemporal_load((const u32x4nt*)p);
  return make_uint4(v[0], v[1], v[2], v[3]);
}
DEV float silu(float x) { return x / (1.f + __expf(-x)); }
DEV float sigm(float x) { return 1.f / (1.f + __expf(-x)); }
DEV float logsigmoid(float x) { return fminf(x, 0.f) - log1pf(__expf(-fabsf(x))); }

typedef __attribute__((ext_vector_type(4))) unsigned u32x4;
typedef __attribute__((ext_vector_type(4))) short s16x4;
DEV bf16x8 tr_frag(const bf* p, int ld) {
  typedef __attribute__((address_space(3))) s16x4 lds_s16x4;
  s16x4 t0 = __builtin_amdgcn_ds_read_tr16_b64_v4i16((lds_s16x4*)p);
  s16x4 t1 = __builtin_amdgcn_ds_read_tr16_b64_v4i16((lds_s16x4*)(p + 4 * ld));
  bf16x8 f = {t0[0], t0[1], t0[2], t0[3], t1[0], t1[1], t1[2], t1[3]};
  return f;
}
template <int BM, int BN, int BK, bool ATOK, bool BTOK, bool PF2 = false, class FA, class FB>
DEV void block_gemm(f32x16 (&acc)[BM / 64][BN / 64], FA getA, FB getB, int nkt, bf* sA, bf* sB, bool zero = true) {
  constexpr int MT = BM / 64, NTl = BN / 64, KV = BK / 8, NA = BM * KV / 256, NB = BN * KV / 256;
  constexpr int LDK = BK + 8;
  constexpr int LDAT = BM + 8, LDBT = BN + 8;
  constexpr int XBUFA = ATOK ? BK * LDAT : BM * LDK, XBUFB = BTOK ? BK * LDBT : BN * LDK;
  const int tid = otid(), lane = tid & 63, w = tid >> 6, wm = w >> 1, wn = w & 1;
  uint4 ra[NA], rb[NB];
  if (zero) {
#pragma unroll
    for (int i = 0; i < MT; i++)
#pragma unroll
      for (int j = 0; j < NTl; j++)
#pragma unroll
        for (int r = 0; r < 16; r++) acc[i][j][r] = 0.f;
  }

#define BG_FETCH(kt, RA, RB)                                                          \
  {                                                                                   \
    _Pragma("unroll") for (int i = 0; i < NA; i++) {                                  \
      int idx = tid + 256 * i;                                                        \
      if (ATOK) RA[i] = getA((kt), idx / (BM / 8), (idx % (BM / 8)) * 8);              \
      else RA[i] = getA((kt), idx / KV, (idx % KV) * 8);                              \
    }                                                                                 \
    _Pragma("unroll") for (int i = 0; i < NB; i++) {                                  \
      int idx = tid + 256 * i;                                                        \
      if (BTOK) RB[i] = getB((kt), idx / (BN / 8), (idx % (BN / 8)) * 8);              \
      else RB[i] = getB((kt), idx / KV, (idx % KV) * 8);                              \
    }                                                                                 \
  }
#define BG_STASH(buf, RA, RB)                                                         \
  {                                                                                   \
    _Pragma("unroll") for (int i = 0; i < NA; i++) {                                  \
      int idx = tid + 256 * i;                                                        \
      if (ATOK) *(uint4*)(sA + (buf) * XBUFA + (idx / (BM / 8)) * LDAT + (idx % (BM / 8)) * 8) = RA[i]; \
      else *(uint4*)(sA + (buf) * XBUFA + (idx / KV) * LDK + (idx % KV) * 8) = RA[i];  \
    }                                                                                 \
    _Pragma("unroll") for (int i = 0; i < NB; i++) {                                  \
      int idx = tid + 256 * i;                                                        \
      if (BTOK) *(uint4*)(sB + (buf) * XBUFB + (idx / (BN / 8)) * LDBT + (idx % (BN / 8)) * 8) = RB[i]; \
      else *(uint4*)(sB + (buf) * XBUFB + (idx / KV) * LDK + (idx % KV) * 8) = RB[i];  \
    }                                                                                 \
  }
#define BG_COMPUTE(buf)                                                               \
  _Pragma("unroll") for (int ks = 0; ks < BK / 16; ks++) {                            \
    bf16x8 a[MT], b[NTl];                                                             \
    _Pragma("unroll") for (int i = 0; i < MT; i++) {                                  \
      if (ATOK) {                                                                     \
        a[i] = tr_frag(sA + (buf) * XBUFA + (ks * 16 + (lane >> 5) * 8 + ((lane & 15) >> 2)) * LDAT + wm * (BM / 2) + i * 32 + \
                       ((lane >> 4) & 1) * 16 + (lane & 3) * 4, LDAT);                \
      } else {                                                                        \
        a[i] = *(const bf16x8*)(sA + (buf) * XBUFA + (wm * (BM / 2) + i * 32 + (lane & 31)) * LDK + ks * 16 + (lane >> 5) * 8); \
      }                                                                               \
    }                                                                                 \
    _Pragma("unroll") for (int j = 0; j < NTl; j++) {                                 \
      if (BTOK) {                                                                     \
        b[j] = tr_frag(sB + (buf) * XBUFB + (ks * 16 + (lane >> 5) * 8 + ((lane & 15) >> 2)) * LDBT + wn * (BN / 2) + j * 32 + \
                       ((lane >> 4) & 1) * 16 + (lane & 3) * 4, LDBT);                \
      } else {                                                                        \
        b[j] = *(const bf16x8*)(sB + (buf) * XBUFB + (wn * (BN / 2) + j * 32 + (lane & 31)) * LDK + ks * 16 + (lane >> 5) * 8); \
      }                                                                               \
    }                                                                                 \
    _Pragma("unroll") for (int i = 0; i < MT; i++)                                    \
      _Pragma("unroll") for (int j = 0; j < NTl; j++)                                 \
        acc[i][j] = __builtin_amdgcn_mfma_f32_32x32x16_bf16(a[i], b[j], acc[i][j], 0, 0, 0); \
  }

  if (PF2) {
    uint4 ra2[NA], rb2[NB];
    BG_FETCH(0, ra, rb);
    BG_FETCH(1, ra2, rb2);
    BG_STASH(0, ra, rb);
    __syncthreads();
#pragma unroll 1
    for (int kt = 0; kt < nkt; kt += 2) {
      const int k2 = min(kt + 2, nkt - 1), k3 = min(kt + 3, nkt - 1);
      BG_FETCH(k2, ra, rb);
      BG_COMPUTE(0);
      BG_STASH(1, ra2, rb2);
      __syncthreads();
      BG_FETCH(k3, ra2, rb2);
      BG_COMPUTE(1);
      BG_STASH(0, ra, rb);
      __syncthreads();
    }
  } else {
    BG_FETCH(0, ra, rb);
    BG_STASH(0, ra, rb);
    __syncthreads();
#pragma unroll 1
    for (int kt = 0; kt < nkt; kt++) {
      const int buf = kt & 1;
      if (kt + 1 < nkt) BG_FETCH(kt + 1, ra, rb);
      BG_COMPUTE(buf);
      if (kt + 1 < nkt) BG_STASH(buf ^ 1, ra, rb);
      __syncthreads();
    }
  }
#undef BG_FETCH
#undef BG_STASH
#undef BG_COMPUTE
}

template <int BM, class FD>
DEV void store_tile_bf16(f32x16 (&acc)[BM / 64][2], bf* Cs, FD dst, int ncols_valid) {
  acc_foreach<BM, 128>(acc, [&](int row, int col, float v) { Cs[row * 136 + col] = f2bf(v); });
  __syncthreads();
  const int tid = otid();
#pragma unroll 4
  for (int i = 0; i < BM / 16; i++) {
    int idx = tid + 256 * i;
    int row = idx >> 4, c8 = (idx & 15) * 8;
    uint4 v = *(const uint4*)(Cs + row * 136 + c8);
    if (c8 < ncols_valid) *(uint4*)(dst(row) + c8) = v;
  }
  __syncthreads();
}

DEV uint4 scale8(uint4 q, float sc) {
  return make_uint4(pack2(lo2f(q.x) * sc, hi2f(q.x) * sc), pack2(lo2f(q.y) * sc, hi2f(q.y) * sc),
                    pack2(lo2f(q.z) * sc, hi2f(q.z) * sc), pack2(lo2f(q.w) * sc, hi2f(q.w) * sc));
}

template <int BM, int BN, class F>
DEV void acc_foreach(f32x16 (&acc)[BM / 64][BN / 64], F f) {
  const int tid_ = otid();
  const int lane = tid_ & 63, w = tid_ >> 6, wm = w >> 1, wn = w & 1;
#pragma unroll
  for (int i = 0; i < BM / 64; i++)
#pragma unroll
    for (int j = 0; j < BN / 64; j++)
#pragma unroll
      for (int r = 0; r < 16; r++) {
        int row = wm * (BM / 2) + i * 32 + (r & 3) + 8 * (r >> 2) + 4 * (lane >> 5);
        int col = wn * (BN / 2) + j * 32 + (lane & 31);
        f(row, col, acc[i][j][r]);
        if (r == 15) asm volatile("" ::: "memory");
      }
}

DEV void conv_tile(const float* __restrict__ src, int srcld, int sn0, int nvalid, bf* __restrict__ dst, int dstld, int n0, int k0,
                   float* tile) {
  const int tid = otid();
  {
    float4 v[4];
#pragma unroll
    for (int i = 0; i < 4; i++) {
      int idx = tid + 256 * i;
      int kk = idx >> 4, n4 = (idx & 15) * 4;
      v[i] = make_float4(0.f, 0.f, 0.f, 0.f);
      if (n4 < nvalid) v[i] = nt_load4(src + (size_t)(k0 + kk) * srcld + sn0 + n4);
    }
#pragma unroll
    for (int i = 0; i < 4; i++) {
      int idx = tid + 256 * i;
      int kk = idx >> 4, n4 = (idx & 15) * 4;
      tile[kk * 65 + n4] = v[i].x; tile[kk * 65 + n4 + 1] = v[i].y; tile[kk * 65 + n4 + 2] = v[i].z; tile[kk * 65 + n4 + 3] = v[i].w;
    }
  }
  __syncthreads();
#pragma unroll 4
  for (int i = 0; i < 16; i++) {
    int idx = tid + 256 * i;
    int nn = idx >> 6, kk = idx & 63;
    int n = n0 + nn;
    dst[(size_t)n * dstld + k0 + kk] = f2bf(tile[kk * 65 + nn]);
  }
  __syncthreads();
}

DEV void phase0a(const Params& p, unsigned char* smem) {
  const int tid = otid();
  float* fs = (float*)smem;
  for (int it = obid(); it < 2 * 114 * 16; it += gridDim.x) {
    int kt = it & 15, nt = (it >> 4) % 114, l = it / (114 * 16);
    const int n0 = nt * 64;
    int sn0 = n0, nvalid = 64;
    if (n0 < 2048) sn0 = n0;
    else if (n0 < CHR) sn0 = n0 + 32;
    else if (n0 < CZC) continue;
    else if (n0 < CHI) sn0 = n0 + 32;
    else if (n0 < CG) continue;
    else if (n0 == CG) { sn0 = SRC_G; nvalid = 32; }
    else { sn0 = 0; nvalid = 0; }
    conv_tile(p.w_in + (size_t)l * D * NIN, NIN, sn0, nvalid, p.wt_in + (size_t)l * NPW * D, D, n0, kt * 64, fs);
  }
  for (int it = obid(); it < 2 * 16 * 32; it += gridDim.x) {
    int kt = it & 31, nt = (it >> 5) & 15, l = it >> 9;
    conv_tile(p.w_out + (size_t)l * 2048 * D, D, nt * 64, 64, p.wt_out + (size_t)l * D * 2048, 2048, nt * 64, kt * 64, fs);
  }
  for (int it = obid(); it < 96; it += gridDim.x) {
    int l = it / 48, j0 = (it % 48) * 64;
    float* sc = fs;
    float* red = fs + 5 * 1024;
    for (int i = tid; i < 5 * 1024; i += 256) {
      int v = i >> 10, k = i & 1023;
      float cv = (v < 4) ? p.c[v * D + k] : p.c_ctx[k];
      sc[i] = silu(cv);
    }
    __syncthreads();
    int col = tid & 63, ks = tid >> 6;
    float a0 = 0, a1 = 0, a2 = 0, a3 = 0, a4 = 0;
    const float* wp = p.w_mod + (size_t)l * D * 3072 + j0 + col;
#pragma unroll 16
    for (int k = ks * 256; k < ks * 256 + 256; k++) {
      float wv = __builtin_nontemporal_load(wp + (size_t)k * 3072);
      a0 += sc[k] * wv; a1 += sc[1024 + k] * wv; a2 += sc[2048 + k] * wv; a3 += sc[3072 + k] * wv; a4 += sc[4096 + k] * wv;
    }
    red[(ks * 5 + 0) * 64 + col] = a0; red[(ks * 5 + 1) * 64 + col] = a1; red[(ks * 5 + 2) * 64 + col] = a2;
    red[(ks * 5 + 3) * 64 + col] = a3; red[(ks * 5 + 4) * 64 + col] = a4;
    __syncthreads();
    for (int i = tid; i < 5 * 64; i += 256) {
      int v = i >> 6, cc = i & 63;
      float s = red[(0 * 5 + v) * 64 + cc] + red[(1 * 5 + v) * 64 + cc] + red[(2 * 5 + v) * 64 + cc] + red[(3 * 5 + v) * 64 + cc];
      p.mod[(l * 5 + v) * 3072 + j0 + cc] = s + p.b_mod[l * 3072 + j0 + cc];
    }
    __syncthreads();
  }
  const int gtid = obid() * 256 + tid, gsz = gridDim.x * 256;
  for (int i = gtid; i < 2 * 4 * 128 * 128; i += gsz) p.wsp[i] = f2bf(p.w_sp[i]);
  for (int i = gtid; i < 128 * 128; i += gsz) {
    int m = i >> 7, k = i & 127;
    int wmm = m >> 6, rip = (m >> 5) & 1, k1 = wmm * 32 + (m & 31);
    int ri = k >> 6, t1 = k & 63;
    float s, c;
    sincospif((float)((k1 * t1) & 63) / 32.f, &s, &c);
    float v = rip == 0 ? (ri == 0 ? c : s) : (ri == 0 ? -s : c);
    p.m1[i] = f2bf(v);
  }
  for (int i = gtid; i < 128 * 256; i += gsz) {
    int k2 = i >> 8, k = i & 255;
    int ri = k >> 7, t2 = k & 127;
    float s, c;
    sincospif((float)((t2 * k2) & 127) / 64.f, &s, &c);
    p.m2[i] = f2bf(ri == 0 ? c : s);
  }
  for (int i = gtid; i < 256 * 512; i += gsz) {
    int tp = i >> 9, k = i & 511;
    int ri = k >> 8, t = k & 255;
    float s, c;
    sincospif((float)((t * tp) & 255) / 128.f, &s, &c);
    p.mctx[i] = f2bf(ri == 0 ? c : s);
  }
  for (int i = gtid; i < 128 * 64; i += gsz) {
    int t2 = i >> 6, k1 = i & 63;
    float s, c;
    sincospif((float)(t2 * k1) / 4096.f, &s, &c);
    p.tw[2 * i] = c;
    p.tw[2 * i + 1] = s;
  }
  __syncthreads();
  if (tid < 128) {
    float s, co;
    sincospif((float)tid / 64.f, &s, &co);
    fs[tid] = co;
    fs[128 + tid] = -s;
  }
  __syncthreads();
  for (int i = gtid; i < 2 * 4 * 128 * 256; i += gsz) {
    int d = i & 127, ri = (i >> 7) & 1, c = (i >> 8) & 127, lg = i >> 15;
    const float* wf = p.w_fno + (size_t)lg * 128 * 128 + d;
    const float* tr = fs + ri * 128;
    float acc = 0.f;
#pragma unroll 8
    for (int cp = 0; cp < 128; cp++) acc += tr[(c * cp) & 127] * wf[cp * 128];
    p.Q[i] = acc * 0.08838834764831845f;
  }
}

DEV void phase0b(const Params& p, unsigned char* smem) {
  const int tid = otid();
  float* wl = (float*)smem;
  for (int it = obid(); it < 256; it += gridDim.x) {
    int l = it >> 7, k0 = (it & 127) * 8;
    const float* wsrc = p.w_in + (size_t)l * D * NIN + (size_t)k0 * NIN + SRC_F;
    {
      float4 wv4[4];
#pragma unroll
      for (int i = 0; i < 4; i++) {
        int idx = tid + 256 * i;
        int kk = idx >> 7, f4 = (idx & 127) * 4;
        wv4[i] = *(const float4*)(wsrc + (size_t)kk * NIN + f4);
      }
#pragma unroll
      for (int i = 0; i < 4; i++) {
        int idx = tid + 256 * i;
        int kk = idx >> 7, f4 = (idx & 127) * 4;
        wl[(f4 + 0) * 8 + kk] = wv4[i].x; wl[(f4 + 1) * 8 + kk] = wv4[i].y; wl[(f4 + 2) * 8 + kk] = wv4[i].z; wl[(f4 + 3) * 8 + kk] = wv4[i].w;
      }
    }
    __syncthreads();
    for (int jj = 0; jj < 4; jj++) {
      int np = tid + 256 * jj;
      int d = np & 127, g = (np >> 7) & 3, ri = np >> 9;
      float acc[8];
#pragma unroll
      for (int kk = 0; kk < 8; kk++) acc[kk] = 0.f;
      const float* qp = p.Q + ((size_t)(l * 4 + g) * 128) * 256 + ri * 128 + d;
      const float* wp = wl + g * 128 * 8;
#pragma unroll 16
      for (int c = 0; c < 128; c++) {
        float qv = qp[c * 256];
        float4 w0 = *(const float4*)(wp + c * 8), w1 = *(const float4*)(wp + c * 8 + 4);
        acc[0] += w0.x * qv; acc[1] += w0.y * qv; acc[2] += w0.z * qv; acc[3] += w0.w * qv;
        acc[4] += w1.x * qv; acc[5] += w1.y * qv; acc[6] += w1.z * qv; acc[7] += w1.w * qv;
      }
      int n = (ri ? CHI : CHR) + g * 128 + d;
      uint4 o = make_uint4(pack2(acc[0], acc[1]), pack2(acc[2], acc[3]), pack2(acc[4], acc[5]), pack2(acc[6], acc[7]));
      *(uint4*)(p.wt_in + ((size_t)l * NPW + n) * D + k0) = o;
    }
    __syncthreads();
  }
}

DEV void phase1(const Params& p, int l) {
  const int lane = otid() & 63, w = otid() >> 6;
  for (int r = obid() * 4 + w; r < ROWS; r += gridDim.x * 4) {
    int b = r / TB, j = r % TB;
    const float* xin;
    int mv;
    if (j < 256) {
      xin = (l == 0 ? p.ctx : p.xc1) + ((size_t)b * 256 + j) * D;
      mv = 4;
    } else {
      xin = (l == 0 ? p.x : p.out) + ((size_t)b * 8192 + (j - 256)) * D;
      mv = b;
    }
    const float* md = p.mod + (size_t)(l * 5 + mv) * 3072;
    float4 v[4];
    float ss = 0.f;
#pragma unroll
    for (int i = 0; i < 4; i++) {
      v[i] = nt_load4(xin + lane * 4 + 256 * i);
      ss += v[i].x * v[i].x + v[i].y * v[i].y + v[i].z * v[i].z + v[i].w * v[i].w;
    }
#pragma unroll
    for (int off = 32; off; off >>= 1) ss += __shfl_xor(ss, off);
    float rstd = rsqrtf(ss * (1.f / 1024.f) + EPS);
#pragma unroll
    for (int i = 0; i < 4; i++) {
      int col = lane * 4 + 256 * i;
      float4 g = *(const float4*)(p.g_pre + l * D + col);
      float4 sh = *(const float4*)(md + col);
      float4 sc = *(const float4*)(md + 1024 + col);
      float o0 = v[i].x * rstd * g.x * (1.f + sc.x) + sh.x;
      float o1 = v[i].y * rstd * g.y * (1.f + sc.y) + sh.y;
      float o2 = v[i].z * rstd * g.z * (1.f + sc.z) + sh.z;
      float o3 = v[i].w * rstd * g.w * (1.f + sc.w) + sh.w;
      *(uint2*)(p.hN + (size_t)r * D + col) = make_uint2(pack2(o0, o1), pack2(o2, o3));
    }
  }
}

DEV void phase2(const Params& p, int l, int hf, unsigned char* smem) {
  bf* sA = (bf*)smem;
  bf* sB = (bf*)(smem + 40960);
  const int bid = obid();
  const int nxb = gridDim.x >> 3, xcd = bid & 7, lb = bid >> 3;
  const int per = (66 * 57 + 7) / 8;
  const int tend = min((xcd + 1) * per, 66 * 57);
  for (int t = xcd * per + lb; t < tend; t += nxb) {
    int ms, rem, rows_in;
    if (t < 8 * 8 * 57) { ms = t / 456; rem = t - ms * 456; rows_in = 8; }
    else { ms = 8; rem = t - 8 * 456; rows_in = 2; }
    int ns = rem / (rows_in * 8);
    if (ns > 7) ns = 7;
    int r2 = rem - ns * rows_in * 8;
    int mt = ms * 8 + (r2 % rows_in), nt = ns * 8 + (r2 / rows_in);
    const bf* A = p.hN + ((size_t)hf * HROWS + mt * 256) * D;
    const bf* B = p.wt_in + ((size_t)l * NPW + nt * 128) * D;
    f32x16 acc[4][2];
    auto gA = [&](int kt, int r, int ko) -> uint4 { return *(const uint4*)(A + (unsigned)(r * D + kt * 32 + ko)); };
    auto gB = [&](int kt, int r, int ko) -> uint4 { return *(const uint4*)(B + (unsigned)(r * D + kt * 32 + ko)); };
    block_gemm<256, 128, 32, false, false, true>(acc, gA, gB, 32, sA, sB);
    if (nt == CG / 128) {
      acc_foreach<256, 128>(acc, [&](int row, int col, float v) {
        if (col < 32) p.gates[(unsigned)((mt * 256 + row) * 32 + col)] = v + p.b_gate[l * 32 + col];
      });
    }
    store_tile_bf16<256>(acc, (bf*)smem, [&](int row) -> bf* { return p.P + pidx(mt * 256 + row, nt * 128); }, min(128, NP - nt * 128));
  }
}

DEV void gate_prep(const float* __restrict__ gch, int h, float* vec, bool want_w) {
  const int tid = otid(), lane = tid & 63, w = tid >> 6;
  if (w < 2) {
    const int d = w;
    int p0 = 2 * lane, p1 = p0 + 1;
    int i0 = d ? 127 - p0 : p0, i1 = d ? 127 - p1 : p1;
    float ig0 = gch[i0 * 32 + (2 * d) * 8 + h], ig1 = gch[i1 * 32 + (2 * d) * 8 + h];
    float lf0 = logsigmoid(gch[i0 * 32 + (2 * d + 1) * 8 + h]), lf1 = logsigmoid(gch[i1 * 32 + (2 * d + 1) * 8 + h]);
    float incl = lf0 + lf1;
#pragma unroll
    for (int off = 1; off < 64; off <<= 1) {
      float t = __shfl_up(incl, off);
      if (lane >= off) incl += t;
    }
    float b1 = incl, b0 = incl - lf1;
    float a0 = ig0 - b0, a1 = ig1 - b1;
    float mincl = fmaxf(a0, a1);
#pragma unroll
    for (int off = 1; off < 64; off <<= 1) {
      float t = __shfl_up(mincl, off);
      if (lane >= off) mincl = fmaxf(mincl, t);
    }
    float prev = __shfl_up(mincl, 1);
    float pm0 = lane ? fmaxf(prev, a0) : a0, pm1 = mincl;
    float tot = __shfl(b1, 63);
    vec[d * 128 + i0] = ig0;
    vec[d * 128 + i1] = ig1;
    vec[256 + d * 128 + i0] = b0;
    vec[256 + d * 128 + i1] = b1;
    if (want_w) {
      float wl0 = tot - b0 + ig0, wl1 = tot - b1 + ig1;
      float mx = fmaxf(wl0, wl1);
#pragma unroll
      for (int off = 32; off; off >>= 1) mx = fmaxf(mx, __shfl_xor(mx, off));
      vec[512 + d * 128 + i0] = __expf(wl0 - mx);
      vec[512 + d * 128 + i1] = __expf(wl1 - mx);
      if (lane == 0) {
        vec[1152 + d * 2] = tot;
        vec[1152 + d * 2 + 1] = mx;
      }
    } else {
      vec[512 + d * 128 + i0] = pm0;
      vec[512 + d * 128 + i1] = pm1;
      if (lane == 0) vec[1152 + d * 2] = tot;
    }
  }
  __syncthreads();
}

DEV void mlstm_dc_item(const Params& p, int it, unsigned char* smem) {
  bf* sA = (bf*)smem;
  bf* sB = (bf*)(smem + OFF_SB);
  float* vec = (float*)(smem + OFF_VEC);
  const int tid = otid();
  int j = it % 66, h = (it / 66) & 7, bl = it / 528;
  size_t base = (size_t)bl * TB + j * 128;
  gate_prep(p.gates + base * 32, h, vec, true);
  const bf* Pb = p.P;
  const int rb = (int)base;
  for (int d = 0; d < 2; d++) {
    int sid = (bl * 8 + h) * 2 + d;
    bf* slot = p.states + ((size_t)sid * 66 + j) * 8192;
    float* nslot = p.nbuf + ((size_t)sid * 66 + j) * 64;
    const float* wv = vec + 512 + d * 128;
    f32x16 acc[1][2];
    auto gA = [&](int kt, int to, int c) -> uint4 {
      int tok = kt * 64 + to;
      return *(const uint4*)(Pb + pidx(rb + tok, CK + h * 64 + c));
    };
    auto gB = [&](int kt, int to, int c) -> uint4 {
      int tok = kt * 64 + to;
      return scale8(*(const uint4*)(Pb + pidx(rb + tok, CV + h * 128 + c)), wv[tok]);
    };
    block_gemm<64, 128, 64, true, true, true>(acc, gA, gB, 2, sA, sB);
    store_tile_bf16<64>(acc, (bf*)smem, [&](int row) -> bf* { return slot + row * 128; }, 128);
    {
      float* red = vec + 768;
      int dk = tid & 63, part = tid >> 6;
      float sacc = 0.f;
#pragma unroll 8
      for (int t = part * 32; t < part * 32 + 32; t++) sacc += wv[t] * bf2f(Pb[pidx(rb + t, CK + h * 64 + dk)]);
      red[part * 64 + dk] = sacc;
      __syncthreads();
      if (tid < 64) nslot[tid] = red[tid] + red[64 + tid] + red[128 + tid] + red[192 + tid];
    }
    if (tid == 0) {
      p.scal[(sid * 66 + j) * 2] = vec[1152 + d * 2];
      p.scal[(sid * 66 + j) * 2 + 1] = vec[1152 + d * 2 + 1];
    }
  }
  __syncthreads();
}

DEV void sgu_item(const Params& p, int l, int it, unsigned char* smem) {
  bf* sA = (bf*)smem;
  bf* sB = (bf*)(smem + OFF_SB);
  float* rstd = (float*)(smem + OFF_VEC);
  const int tid = otid();
  int g = it & 3, j = (it >> 2) % 66, bl = it / 264;
  size_t base = (size_t)bl * TB + j * 128;
  bf* Pb = p.P;
  const int rb = (int)base;
  {
    int t = tid >> 1, hh = tid & 1;
    float ss = 0.f;
    for (int i = 0; i < 32; i++) {
      uint4 u = *(const uint4*)(Pb + pidx(rb + t, CVS + hh * 256 + i * 8));
      float a;
      a = lo2f(u.x); ss += a * a; a = hi2f(u.x); ss += a * a;
      a = lo2f(u.y); ss += a * a; a = hi2f(u.y); ss += a * a;
      a = lo2f(u.z); ss += a * a; a = hi2f(u.z); ss += a * a;
      a = lo2f(u.w); ss += a * a; a = hi2f(u.w); ss += a * a;
    }
    ss += __shfl_xor(ss, 1);
    if (hh == 0) rstd[t] = rsqrtf(ss * (1.f / 512.f) + EPS);
  }
  __syncthreads();
  const bf* W = p.wsp + (size_t)(l * 4 + g) * 128 * 128;
  const float* gs = p.g_sgu + l * 512 + g * 128;
  f32x16 acc[2][2];
  auto gA = [&](int kt, int r, int ko) -> uint4 { return *(const uint4*)(W + r * 128 + kt * 64 + ko); };
  auto gB = [&](int kt, int to, int c) -> uint4 {
    int tok = kt * 64 + to;
    return scale8(*(const uint4*)(Pb + pidx(rb + tok, CVS + g * 128 + c)), rstd[tok]);
  };
  block_gemm<128, 128, 64, false, true, true>(acc, gA, gB, 2, sA, sB);
  const float* bs = p.b_sp + (size_t)(l * 4 + g) * 128;
  float* Hs = (float*)smem;
  acc_foreach<128, 128>(acc, [&](int t, int c, float v) { Hs[t * 132 + c] = v; });
  __syncthreads();
  {
    const int t = tid >> 1, hh = tid & 1;
    const float* hrow = Hs + t * 132 + hh * 64;
    const float* gp = gs + hh * 64;
    const float bt = bs[t];
#pragma unroll 2
    for (int i = 0; i < 8; i++) {
      bf* up = Pb + pidx(rb + t, CU + g * 128 + hh * 64 + i * 8);
      uint4 uu = *(const uint4*)up;
      uint4 uz = *(const uint4*)(Pb + pidx(rb + t, CZB + g * 128 + hh * 64 + i * 8));
      float4 h0 = *(const float4*)(hrow + i * 8), h1 = *(const float4*)(hrow + i * 8 + 4);
      float4 g0 = *(const float4*)(gp + i * 8), g1 = *(const float4*)(gp + i * 8 + 4);
      float y0 = lo2f(uu.x) * (h0.x * g0.x + bt) * silu(lo2f(uz.x));
      float y1 = hi2f(uu.x) * (h0.y * g0.y + bt) * silu(hi2f(uz.x));
      float y2 = lo2f(uu.y) * (h0.z * g0.z + bt) * silu(lo2f(uz.y));
      float y3 = hi2f(uu.y) * (h0.w * g0.w + bt) * silu(hi2f(uz.y));
      float y4 = lo2f(uu.z) * (h1.x * g1.x + bt) * silu(lo2f(uz.z));
      float y5 = hi2f(uu.z) * (h1.y * g1.y + bt) * silu(hi2f(uz.z));
      float y6 = lo2f(uu.w) * (h1.z * g1.z + bt) * silu(lo2f(uz.w));
      float y7 = hi2f(uu.w) * (h1.w * g1.w + bt) * silu(hi2f(uz.w));
      *(uint4*)up = make_uint4(pack2(y0, y1), pack2(y2, y3), pack2(y4, y5), pack2(y6, y7));
    }
  }
  __syncthreads();
}

DEV void fourA_item(const Params& p, int it, unsigned char* smem) {
  bf* sA = (bf*)smem;
  bf* sB = (bf*)(smem + OFF_SB);
  int cht = it & 3, t2 = (it >> 2) & 127, bl = it >> 9;
  const bf* Pb = p.P;
  const int rb = bl * TB + 256 + t2;
  f32x16 acc[2][2];
  auto gA = [&](int kt, int r, int ko) -> uint4 { return *(const uint4*)(p.m1 + r * 128 + kt * 64 + ko); };
  auto gB = [&](int kt, int to, int c) -> uint4 {
    int ri = kt, t1 = to;
    return *(const uint4*)(Pb + pidx(rb + t1 * 128, (ri ? CHI : CHR) + cht * 128 + c));
  };
  block_gemm<128, 128, 64, false, true, true>(acc, gA, gB, 2, sA, sB);
  float* Ha = (float*)smem;
  acc_foreach<128, 128>(acc, [&](int m, int c, float v) { Ha[m * 132 + c] = v; });
  __syncthreads();
  {
    const int tid = otid();
    const int k1 = tid >> 2, cq = (tid & 3) * 32;
    const float* ar = Ha + ((k1 >> 5) * 64 + (k1 & 31)) * 132 + cq;
    const float* ai = ar + 32 * 132;
    const float c = p.tw[(t2 * 64 + k1) * 2], sn = p.tw[(t2 * 64 + k1) * 2 + 1];
    bf* ore = p.abuf + ((((((size_t)bl * 64 + k1) * 4 + cht) * 2) * 128 + t2) * 128) + cq;
    bf* oim = ore + (size_t)128 * 128;
#pragma unroll
    for (int i = 0; i < 4; i++) {
      float4 r0 = *(const float4*)(ar + i * 8), r1 = *(const float4*)(ar + i * 8 + 4);
      float4 i0 = *(const float4*)(ai + i * 8), i1 = *(const float4*)(ai + i * 8 + 4);
      *(uint4*)(ore + i * 8) = make_uint4(pack2(r0.x * c + i0.x * sn, r0.y * c + i0.y * sn), pack2(r0.z * c + i0.z * sn, r0.w * c + i0.w * sn),
                                          pack2(r1.x * c + i1.x * sn, r1.y * c + i1.y * sn), pack2(r1.z * c + i1.z * sn, r1.w * c + i1.w * sn));
      *(uint4*)(oim + i * 8) = make_uint4(pack2(i0.x * c - r0.x * sn, i0.y * c - r0.y * sn), pack2(i0.z * c - r0.z * sn, i0.w * c - r0.w * sn),
                                          pack2(i1.x * c - r1.x * sn, i1.y * c - r1.y * sn), pack2(i1.z * c - r1.z * sn, i1.w * c - r1.w * sn));
    }
  }
  __syncthreads();
}

DEV void fourCtx_item(const Params& p, int l, int it, unsigned char* smem) {
  bf* sA = (bf*)smem;
  bf* sB = (bf*)(smem + OFF_SB);
  int mt = it & 1, g = (it >> 1) & 3, bl = it >> 3;
  const bf* Pb = p.P;
  const int rb = bl * TB;
  f32x16 acc[2][2];
  auto gA = [&](int kt, int r, int ko) -> uint4 { return *(const uint4*)(p.mctx + (mt * 128 + r) * 512 + kt * 64 + ko); };
  auto gB = [&](int kt, int to, int c) -> uint4 {
    int ri = kt >> 2, t = (kt & 3) * 64 + to;
    return *(const uint4*)(Pb + pidx(rb + t, (ri ? CHI : CHR) + g * 128 + c));
  };
  block_gemm<128, 128, 64, false, true, true>(acc, gA, gB, 8, sA, sB);
  float* Hs = (float*)smem;
  acc_foreach<128, 128>(acc, [&](int tl, int d, float v) { Hs[tl * 132 + d] = v; });
  __syncthreads();
  {
    const int tid = otid();
    const int tl = tid >> 1, hh = tid & 1;
    const int tp = mt * 128 + tl;
    const float* hrow = Hs + tl * 132 + hh * 64;
    const float* bp = p.b_fno + l * 512 + g * 128 + hh * 64;
    bf* op = p.cbuf + ((size_t)bl * 256 + tp) * 512 + g * 128 + hh * 64;
#pragma unroll 2
    for (int i = 0; i < 8; i++) {
      uint4 uz = *(const uint4*)(Pb + pidx(rb + tp, CZC + g * 128 + hh * 64 + i * 8));
      float4 h0 = *(const float4*)(hrow + i * 8), h1 = *(const float4*)(hrow + i * 8 + 4);
      float4 b0 = *(const float4*)(bp + i * 8), b1 = *(const float4*)(bp + i * 8 + 4);
      float y0 = (h0.x * 0.0625f + b0.x) * silu(lo2f(uz.x)), y1 = (h0.y * 0.0625f + b0.y) * silu(hi2f(uz.x));
      float y2 = (h0.z * 0.0625f + b0.z) * silu(lo2f(uz.y)), y3 = (h0.w * 0.0625f + b0.w) * silu(hi2f(uz.y));
      float y4 = (h1.x * 0.0625f + b1.x) * silu(lo2f(uz.z)), y5 = (h1.y * 0.0625f + b1.y) * silu(hi2f(uz.z));
      float y6 = (h1.z * 0.0625f + b1.z) * silu(lo2f(uz.w)), y7 = (h1.w * 0.0625f + b1.w) * silu(hi2f(uz.w));
      *(uint4*)(op + i * 8) = make_uint4(pack2(y0, y1), pack2(y2, y3), pack2(y4, y5), pack2(y6, y7));
    }
  }
  __syncthreads();
}

DEV void phase3(const Params& p, int l, unsigned char* smem) {
  const int n0 = 1056, n1 = n0 + 528, n2 = n1 + 1024, n3 = n2 + 16;
  for (int it = obid(); it < n3; it += gridDim.x) {
    if (it < n0) mlstm_dc_item(p, it, smem);
    else if (it < n1) sgu_item(p, l, it - n0, smem);
    else if (it < n2) fourA_item(p, it - n1, smem);
    else fourCtx_item(p, l, it - n2, smem);
  }
}

DEV int chunk_at(int d, int pp) { return d ? (pp == 0 ? 1 : (pp == 1 ? 0 : 67 - pp)) : pp; }
DEV void scan_item(const Params& p, int it, unsigned char* smem) {
  float* tab = (float*)(smem + OFF_VEC);
  const int tid = otid();
  int eb = it & 15, sid = it >> 4;
  int d = sid & 1;
  if (tid < 66) {
    int j = chunk_at(d, tid);
    tab[256 + tid] = p.scal[(sid * 66 + j) * 2];
    tab[384 + tid] = p.scal[(sid * 66 + j) * 2 + 1];
  }
  __syncthreads();
  if (tid == 0) {
    float m = 0.f;
    for (int pp = 0; pp < 66; pp++) {
      float bl_ = tab[256 + pp], ml = tab[384 + pp];
      float mn = fmaxf(bl_ + m, ml);
      tab[pp] = __expf(bl_ + m - mn);
      tab[128 + pp] = __expf(ml - mn);
      if (eb == 0) p.mstart[sid * 66 + chunk_at(d, pp)] = m;
      m = mn;
    }
  }
  __syncthreads();
  {
    float v0 = 0.f, v1 = 0.f;
    unsigned* basep = (unsigned*)(p.states + (size_t)sid * 66 * 8192) + eb * 256 + tid;
#pragma unroll 1
    for (int pb = 0; pb < 66; pb += 33) {
      unsigned dv[33];
#pragma unroll
      for (int u = 0; u < 33; u++) dv[u] = basep[(size_t)chunk_at(d, pb + u) * 4096];
#pragma unroll
      for (int u = 0; u < 33; u++) {
        basep[(size_t)chunk_at(d, pb + u) * 4096] = pack2(v0, v1);
        float de = tab[pb + u], sc = tab[128 + pb + u];
        v0 = de * v0 + sc * lo2f(dv[u]);
        v1 = de * v1 + sc * hi2f(dv[u]);
      }
    }
  }
  if (eb == 0 && tid < 64) {
    float val = 0.f;
    float* basep = p.nbuf + (size_t)sid * 66 * 64 + tid;
#pragma unroll 1
    for (int pb = 0; pb < 66; pb += 33) {
      float dv[33];
#pragma unroll
      for (int u = 0; u < 33; u++) dv[u] = basep[chunk_at(d, pb + u) * 64];
#pragma unroll
      for (int u = 0; u < 33; u++) {
        basep[chunk_at(d, pb + u) * 64] = val;
        val = tab[pb + u] * val + tab[128 + pb + u] * dv[u];
      }
    }
  }
  __syncthreads();
}

DEV void fourC_item(const Params& p, int l, int it, unsigned char* smem) {
  bf* sA = (bf*)smem;
  bf* sB = (bf*)(smem + OFF_SB);
  int g = it & 3, k1 = (it >> 2) & 63, bl = it >> 8;
  const bf* Ab = p.abuf + ((((size_t)bl * 64 + k1) * 4 + g) * 2) * 128 * 128;
  f32x16 acc[2][2];
  auto gA = [&](int kt, int r, int ko) -> uint4 { return *(const uint4*)(p.m2 + r * 256 + kt * 64 + ko); };
  auto gB = [&](int kt, int to, int c) -> uint4 {
    int kk = kt * 64 + to;
    return nt_load16(Ab + (unsigned)(kk * 128 + c));
  };
  block_gemm<128, 128, 64, false, true, true>(acc, gA, gB, 4, sA, sB);
  bf* Pb = p.P;
  const int rb = bl * TB + 256;
  float* Hs = (float*)smem;
  acc_foreach<128, 128>(acc, [&](int k2, int d, float v) { Hs[k2 * 132 + d] = v; });
  __syncthreads();
  {
    const int tid = otid();
    const int k2 = tid >> 1, hh = tid & 1;
    const int tp = k1 + 64 * k2;
    const float* hrow = Hs + k2 * 132 + hh * 64;
    const float* bp = p.b_fno + l * 512 + g * 128 + hh * 64;
    const float sc = 0.011048543456039806f;
#pragma unroll 2
    for (int i = 0; i < 8; i++) {
      uint4 uz = *(const uint4*)(Pb + pidx(rb + tp, CZC + g * 128 + hh * 64 + i * 8));
      bf* op = Pb + pidx(rb + tp, CHR + g * 128 + hh * 64 + i * 8);
      float4 h0 = *(const float4*)(hrow + i * 8), h1 = *(const float4*)(hrow + i * 8 + 4);
      float4 b0 = *(const float4*)(bp + i * 8), b1 = *(const float4*)(bp + i * 8 + 4);
      float y0 = (h0.x * sc + b0.x) * silu(lo2f(uz.x)), y1 = (h0.y * sc + b0.y) * silu(hi2f(uz.x));
      float y2 = (h0.z * sc + b0.z) * silu(lo2f(uz.y)), y3 = (h0.w * sc + b0.w) * silu(hi2f(uz.y));
      float y4 = (h1.x * sc + b1.x) * silu(lo2f(uz.z)), y5 = (h1.y * sc + b1.y) * silu(hi2f(uz.z));
      float y6 = (h1.z * sc + b1.z) * silu(lo2f(uz.w)), y7 = (h1.w * sc + b1.w) * silu(hi2f(uz.w));
      *(uint4*)op = make_uint4(pack2(y0, y1), pack2(y2, y3), pack2(y4, y5), pack2(y6, y7));
    }
  }
  __syncthreads();
}

DEV void phase4(const Params& p, int l, unsigned char* smem) {
  const int n0 = 512, n1 = n0 + 32 * 16;
  for (int it = obid(); it < n1; it += gridDim.x) {
    if (it < n0) fourC_item(p, l, it, smem);
    else scan_item(p, it - n0, smem);
  }
  for (int i = obid() * 256 + otid(); i < 2 * 256 * 512; i += gridDim.x * 256) {
    int c = i & 511, t = (i >> 9) & 255, bl = i >> 17;
    p.P[pidx(bl * TB + t, CHR + c)] = p.cbuf[i];
  }
}

DEV void mlstm_out_item(const Params& p, int l, int it, unsigned char* smem) {
  bf* sA = (bf*)smem;
  bf* sB = (bf*)(smem + OFF_SB32);
  bf* Sl = (bf*)(smem + OFF_SL);
  float* vec = (float*)(smem + OFF_VEC);
  float* mrow = vec + 768;
  float* winter = vec + 896;
  float* dinv = vec + 1024;
  float* nst = vec + 1160;
  const int tid = otid(), lane = tid & 63, w = tid >> 6, wm = w >> 1, wn = w & 1;
  int j, h, bl;
  if (l == 0) { j = it % 66; h = (it / 66) & 7; bl = it / 528; }
  else { j = 2 + (it & 63); h = (it >> 6) & 7; bl = it >> 9; }
  size_t base = (size_t)bl * TB + j * 128;
  gate_prep(p.gates + base * 32, h, vec, false);
  bf* Pb = p.P;
  const int rb = (int)base;
  f32x16 acch[2][2];
  for (int d = 0; d < 2; d++) {
    int sid = (bl * 8 + h) * 2 + d;
    const bf* slot = p.states + ((size_t)sid * 66 + j) * 8192;
    const float* nslot = p.nbuf + ((size_t)sid * 66 + j) * 64;
    const float* igv = vec + d * 128;
    const float* bv = vec + 256 + d * 128;
    const float* pmv = vec + 512 + d * 128;
    float ms = p.mstart[sid * 66 + j];
    if (tid < 128) {
      float inter = bv[tid] + ms;
      float mr = fmaxf(inter, bv[tid] + pmv[tid]);
      mrow[tid] = mr;
      winter[tid] = __expf(inter - mr);
    } else if (tid < 192) {
      nst[tid - 128] = nslot[tid - 128];
    }
    __syncthreads();
    {
      f32x16 acc[2][2];
      auto gA = [&](int kt, int r, int ko) -> uint4 { return *(const uint4*)(Pb + pidx(rb + r, CQ + h * 64 + ko)); };
      auto gB = [&](int kt, int r, int ko) -> uint4 { return nt_load16(Pb + pidx(rb + r, CK + h * 64 + ko)); };
      block_gemm<128, 128, 64, false, false>(acc, gA, gB, 1, sA, sB);
      acc_foreach<128, 128>(acc, [&](int t, int s, float v) { Sl[t * 136 + s] = f2bf(v); });
    }
    __syncthreads();
#pragma unroll 1
    for (int i = 0; i < 8; i++) {
      int idx = tid + 256 * i;
      int t = idx >> 4, s0 = (idx & 15) * 8;
      uint4 u = *(const uint4*)(Sl + t * 136 + s0);
      float rowc = bv[t] - mrow[t];
      float4 b0 = *(const float4*)(bv + s0), b1 = *(const float4*)(bv + s0 + 4);
      float4 g0 = *(const float4*)(igv + s0), g1 = *(const float4*)(igv + s0 + 4);
      float e[8];
      e[0] = lo2f(u.x) * __expf(rowc - b0.x + g0.x); e[1] = hi2f(u.x) * __expf(rowc - b0.y + g0.y);
      e[2] = lo2f(u.y) * __expf(rowc - b0.z + g0.z); e[3] = hi2f(u.y) * __expf(rowc - b0.w + g0.w);
      e[4] = lo2f(u.z) * __expf(rowc - b1.x + g1.x); e[5] = hi2f(u.z) * __expf(rowc - b1.y + g1.y);
      e[6] = lo2f(u.w) * __expf(rowc - b1.z + g1.z); e[7] = hi2f(u.w) * __expf(rowc - b1.w + g1.w);
#pragma unroll
      for (int q = 0; q < 8; q++) {
        int sq = s0 + q;
        bool ok = d ? (sq >= t) : (sq <= t);
        e[q] = ok ? 0.125f * e[q] : 0.f;
      }
      *(uint4*)(Sl + t * 136 + s0) = make_uint4(pack2(e[0], e[1]), pack2(e[2], e[3]), pack2(e[4], e[5]), pack2(e[6], e[7]));
    }
    __syncthreads();
    {
      int t = tid >> 1, hh = tid & 1;
      float rs = 0.f, qn = 0.f;
#pragma unroll
      for (int i = 0; i < 8; i++) {
        uint4 u = *(const uint4*)(Sl + t * 136 + hh * 64 + i * 8);
        rs += lo2f(u.x) + hi2f(u.x) + lo2f(u.y) + hi2f(u.y) + lo2f(u.z) + hi2f(u.z) + lo2f(u.w) + hi2f(u.w);
      }
      const bf* qp = Pb + pidx(rb + t, CQ + h * 64 + hh * 32);
      const float* np_ = nst + hh * 32;
#pragma unroll
      for (int i = 0; i < 4; i++) {
        uint4 u = *(const uint4*)(qp + i * 8);
        qn += lo2f(u.x) * np_[i * 8 + 0] + hi2f(u.x) * np_[i * 8 + 1] + lo2f(u.y) * np_[i * 8 + 2] + hi2f(u.y) * np_[i * 8 + 3] +
              lo2f(u.z) * np_[i * 8 + 4] + hi2f(u.z) * np_[i * 8 + 5] + lo2f(u.w) * np_[i * 8 + 6] + hi2f(u.w) * np_[i * 8 + 7];
      }
      rs += __shfl_xor(rs, 1);
      qn += __shfl_xor(qn, 1);
      if (hh == 0) {
        float den = rs + winter[t] * 0.125f * qn;
        dinv[t] = 1.f / fmaxf(fabsf(den), __expf(-mrow[t]));
      }
    }
    __syncthreads();
    {
      auto gA = [&](int kt, int r, int ko) -> uint4 {
        if (kt < 4) return scale8(*(const uint4*)(Sl + r * 136 + kt * 32 + ko), dinv[r]);
        uint4 q = *(const uint4*)(Pb + pidx(rb + r, CQ + h * 64 + (kt - 4) * 32 + ko));
        return scale8(q, winter[r] * 0.125f * dinv[r]);
      };
      auto gB = [&](int kt, int to, int c) -> uint4 {
        if (kt < 4) return nt_load16(Pb + pidx(rb + kt * 32 + to, CV + h * 128 + c));
        return nt_load16(slot + ((kt - 4) * 32 + to) * 128 + c);
      };
      block_gemm<128, 128, 32, false, true, true>(acch, gA, gB, 6, sA, sB, d == 0);
    }
    __syncthreads();
  }
  float* Hs = (float*)smem;
  acc_foreach<128, 128>(acch, [&](int t, int c, float v) { Hs[t * 132 + c] = v; });
  __syncthreads();
  {
    const int t = tid >> 1, hh = tid & 1;
    const float* hrow = Hs + t * 132 + hh * 64;
    float ss = 0.f;
#pragma unroll 4
    for (int i = 0; i < 16; i++) {
      float4 v = *(const float4*)(hrow + i * 4);
      ss += v.x * v.x + v.y * v.y + v.z * v.z + v.w * v.w;
    }
    ss += __shfl_xor(ss, 1);
    const float rstd = rsqrtf(ss * (1.f / 128.f) + EPS);
    const float* gh = p.g_hnorm + l * D + h * 128 + hh * 64;
#pragma unroll 2
    for (int i = 0; i < 8; i++) {
      bf* op = Pb + pidx(rb + t, CO + h * 128 + hh * 64 + i * 8);
      uint4 uo = *(const uint4*)op;
      uint4 uz = *(const uint4*)(Pb + pidx(rb + t, CZA + h * 128 + hh * 64 + i * 8));
      float4 h0 = *(const float4*)(hrow + i * 8), h1 = *(const float4*)(hrow + i * 8 + 4);
      float4 g0 = *(const float4*)(gh + i * 8), g1 = *(const float4*)(gh + i * 8 + 4);
      float y0 = h0.x * rstd * g0.x * sigm(lo2f(uo.x)) * silu(lo2f(uz.x));
      float y1 = h0.y * rstd * g0.y * sigm(hi2f(uo.x)) * silu(hi2f(uz.x));
      float y2 = h0.z * rstd * g0.z * sigm(lo2f(uo.y)) * silu(lo2f(uz.y));
      float y3 = h0.w * rstd * g0.w * sigm(hi2f(uo.y)) * silu(hi2f(uz.y));
      float y4 = h1.x * rstd * g1.x * sigm(lo2f(uo.z)) * silu(lo2f(uz.z));
      float y5 = h1.y * rstd * g1.y * sigm(hi2f(uo.z)) * silu(hi2f(uz.z));
      float y6 = h1.z * rstd * g1.z * sigm(lo2f(uo.w)) * silu(lo2f(uz.w));
      float y7 = h1.w * rstd * g1.w * sigm(hi2f(uo.w)) * silu(hi2f(uz.w));
      *(uint4*)op = make_uint4(pack2(y0, y1), pack2(y2, y3), pack2(y4, y5), pack2(y6, y7));
    }
  }
  __syncthreads();
}

DEV void phase6(const Params& p, int l, unsigned char* smem) {
  bf* sA = (bf*)smem;
  bf* sB = (bf*)(smem + OFF_SB);
  const int bid = obid();
  const int nxb = gridDim.x >> 3, xcd = bid & 7, lb = bid >> 3;
  if (l == 1) {
    bf* sA2 = (bf*)smem;
    bf* sB2 = (bf*)(smem + 40960);
    for (int t = xcd * 64 + lb; t < (xcd + 1) * 64; t += nxb) {
      int m256 = (t >> 6) * 8 + (t & 7), nt = (t >> 3) & 7;
      int rowbase = (m256 >> 5) * TB + 256 + (m256 & 31) * 256;
      const bf* A = p.P;
      const bf* B = p.wt_out + ((size_t)l * D + nt * 128) * 2048;
      f32x16 acc[4][2];
      auto gA = [&](int kt, int r, int ko) -> uint4 {
        int k = kt * 32;
        int col = (kt < 32 ? CO + k : (kt < 48 ? CU + (k - 1024) : CHR + (k - 1536))) + ko;
        return *(const uint4*)(A + pidx(rowbase + r, col));
      };
      auto gB = [&](int kt, int r, int ko) -> uint4 { return *(const uint4*)(B + (unsigned)(r * 2048 + kt * 32 + ko)); };
      block_gemm<256, 128, 32, false, false, true>(acc, gA, gB, 64, sA2, sB2);
      bf* Yt = p.ybuf + (size_t)rowbase * D + nt * 128;
      store_tile_bf16<256>(acc, (bf*)smem, [&](int row) -> bf* { return Yt + (unsigned)(row * D); }, 128);
    }
    return;
  }
  const int nmt = (l == 0) ? 132 : 128;
  const int per = nmt;
  for (int t = xcd * per + lb; t < (xcd + 1) * per; t += nxb) {
    int mtl, nt;
    if (t < 1024) { mtl = (t >> 6) * 8 + (t & 7); nt = (t >> 3) & 7; }
    else { mtl = 128 + ((t - 1024) & 3); nt = (t - 1024) >> 2; }
    int rowbase = (l == 0) ? mtl * 128 : ((mtl >> 6) * TB + 256 + (mtl & 63) * 128);
    const int mt = rowbase >> 7;
    const bf* A = p.P;
    const bf* B = p.wt_out + ((size_t)l * D + nt * 128) * 2048;
    f32x16 acc[2][2];
    auto gA = [&](int kt, int r, int ko) -> uint4 {
      int k = kt * 64;
      int col = (kt < 16 ? CO + k : (kt < 24 ? CU + (k - 1024) : CHR + (k - 1536))) + ko;
      return *(const uint4*)(A + pidx(rowbase + r, col));
    };
    auto gB = [&](int kt, int r, int ko) -> uint4 { return *(const uint4*)(B + (unsigned)(r * 2048 + kt * 64 + ko)); };
    block_gemm<128, 128, 64, false, false, true>(acc, gA, gB, 32, sA, sB);
    bf* Yt = p.ybuf + (size_t)mt * 128 * D + nt * 128;
    store_tile_bf16<128>(acc, (bf*)smem, [&](int row) -> bf* { return Yt + (unsigned)(row * D); }, 128);
  }
}

DEV void phase7(const Params& p, int l, int hf) {
  const int lane = otid() & 63, w = otid() >> 6;
  for (int rl = obid() * 4 + w; rl < HROWS; rl += gridDim.x * 4) {
    int r = hf * HROWS + rl;
    int b = r / TB, j = r % TB;
    const float* xin;
    float* xo;
    int mv;
    if (j < 256) {
      if (l != 0) continue;
      xin = p.ctx + ((size_t)b * 256 + j) * D;
      xo = p.xc1 + ((size_t)b * 256 + j) * D;
      mv = 4;
    } else {
      xin = (l == 0 ? p.x : p.out) + ((size_t)b * 8192 + (j - 256)) * D;
      xo = p.out + ((size_t)b * 8192 + (j - 256)) * D;
      mv = b;
    }
    const float* gt = p.mod + (size_t)(l * 5 + mv) * 3072 + 2048;
    const bf* yp = p.ybuf + (size_t)rl * D;
    float y[16];
    float ss = 0.f;
#pragma unroll
    for (int i = 0; i < 4; i++) {
      uint2 u = *(const uint2*)(yp + lane * 4 + 256 * i);
      y[i * 4 + 0] = lo2f(u.x); y[i * 4 + 1] = hi2f(u.x); y[i * 4 + 2] = lo2f(u.y); y[i * 4 + 3] = hi2f(u.y);
      ss += y[i * 4] * y[i * 4] + y[i * 4 + 1] * y[i * 4 + 1] + y[i * 4 + 2] * y[i * 4 + 2] + y[i * 4 + 3] * y[i * 4 + 3];
    }
#pragma unroll
    for (int off = 32; off; off >>= 1) ss += __shfl_xor(ss, off);
    float rstd = rsqrtf(ss * (1.f / 1024.f) + EPS);
#pragma unroll
    for (int i = 0; i < 4; i++) {
      int col = lane * 4 + 256 * i;
      float4 xv = nt_load4(xin + col);
      float4 g = *(const float4*)(p.g_post + l * D + col);
      float4 gv = *(const float4*)(gt + col);
      float4 o;
      o.x = xv.x + gv.x * (y[i * 4 + 0] * rstd * g.x);
      o.y = xv.y + gv.y * (y[i * 4 + 1] * rstd * g.y);
      o.z = xv.z + gv.z * (y[i * 4 + 2] * rstd * g.z);
      o.w = xv.w + gv.w * (y[i * 4 + 3] * rstd * g.w);
      nt_store4(xo + col, o);
    }
  }
}


#define XB_TMO      128
#define XB_XCNT(j)  (256  + 64 * (j))
#define XB_XSUB(j)  (1280 + 64 * (j))
#define XB_XGEN(j)  (2304 + 64 * (j))
#define XB_TOP      3328
#define XB_TOPGEN   3392
#define XCD_BAR_WORDS 3456
#define XB_SPIN_CAP (1u << 18)
#define LAS __attribute__((address_space(3)))
DEV unsigned xb_ld(unsigned* p) { return __hip_atomic_load(p, __ATOMIC_RELAXED, __HIP_MEMORY_SCOPE_AGENT); }
DEV unsigned xb_add(unsigned* p, unsigned v) { return __hip_atomic_fetch_add(p, v, __ATOMIC_RELAXED, __HIP_MEMORY_SCOPE_AGENT); }
DEV unsigned xb_xcc_id() { return (unsigned)__builtin_amdgcn_s_getreg((3 << 11) | 20) & 0xFu; }
#define XB_SPIN(cond, bar) do { unsigned _sp = 0; while (cond) { __builtin_amdgcn_s_sleep(1); \
    if ((++_sp & 255u) == 0u) { if (xb_ld(&(bar)[XB_TMO])) break; if (_sp > XB_SPIN_CAP) { atomicAdd(&(bar)[XB_TMO], 1u); break; } } } } while (0)
struct XcdBarrier {
  unsigned* bar;
  unsigned x;
  volatile LAS unsigned* st;
};
DEV XcdBarrier xcd_barrier_post(unsigned* bar, volatile LAS unsigned* st) {
  XcdBarrier b;
  b.bar = bar;
  b.x = xb_xcc_id();
  b.st = st;
  if (threadIdx.x == 0) (void)xb_add(&bar[XB_XCNT(b.x)], 1u);
  return b;
}
DEV void xcd_barrier_complete(unsigned* bar, unsigned x, unsigned& nloc, unsigned& nx) {
  const unsigned G = gridDim.x * gridDim.y * gridDim.z;
  unsigned sum, cnt, mine, sp = 0u;
  for (;;) {
    sum = 0u; cnt = 0u; mine = 0u;
#pragma unroll
    for (unsigned j = 0; j < 16; ++j) {
      const unsigned c = xb_ld(&bar[XB_XCNT(j)]);
      sum += c;
      cnt += (c > 0u) ? 1u : 0u;
      mine = (j == x) ? c : mine;
    }
    if (sum == G) break;
    __builtin_amdgcn_s_sleep(1);
    if ((++sp & 255u) == 0u) {
      if (xb_ld(&bar[XB_TMO])) break;
      if (sp > XB_SPIN_CAP) { atomicAdd(&bar[XB_TMO], 1u); break; }
    }
  }
  nloc = mine > 0u ? mine : 1u;
  nx = cnt > 0u ? cnt : 1u;
}
DEV void xcd_barrier(const XcdBarrier& b) {
  asm volatile("s_waitcnt vmcnt(0)" ::: "memory");
  __syncthreads();
  if (threadIdx.x == 0) {
    unsigned* bar = b.bar;
    __builtin_amdgcn_s_waitcnt(0);
    unsigned nloc = b.st[0], nx = b.st[1];
    if (nloc == 0u) {
      xcd_barrier_complete(bar, b.x, nloc, nx);
      b.st[0] = nloc;
      b.st[1] = nx;
    }
    const unsigned old = xb_add(&bar[XB_XSUB(b.x)], 1u);
    const unsigned gen = old / nloc;
    if (old + 1u == (gen + 1u) * nloc) {
      __builtin_amdgcn_fence(__ATOMIC_RELEASE, "agent");
      asm volatile("s_waitcnt vmcnt(0)" ::: "memory");
      const unsigned og = xb_add(&bar[XB_TOP], 1u);
      const unsigned tg = og / nx;
      if (og + 1u == (tg + 1u) * nx) xb_add(&bar[XB_TOPGEN], 1u);
      else XB_SPIN(xb_ld(&bar[XB_TOPGEN]) == tg, bar);
      __builtin_amdgcn_fence(__ATOMIC_ACQUIRE, "agent");
      xb_add(&bar[XB_XGEN(b.x)], 1u);
      asm volatile("s_waitcnt vmcnt(0)" ::: "memory");
    } else {
      XB_SPIN(xb_ld(&bar[XB_XGEN(b.x)]) == gen, bar);
      __builtin_amdgcn_fence(__ATOMIC_ACQUIRE, "agent");
      asm volatile("s_waitcnt vmcnt(0)" ::: "memory");
    }
  }
  __syncthreads();
}

__global__ void __launch_bounds__(256, 2) mk_forward(Params p) {
  extern __shared__ __attribute__((aligned(16))) unsigned char smem[];
  cg::grid_group grid = cg::this_grid();
  volatile LAS unsigned* xst = (volatile LAS unsigned*)(smem + LDS_BYTES - 16);
  if (threadIdx.x == 0) { xst[0] = 0u; xst[1] = 0u; xst[2] = 0u; xst[3] = 0u; }
  __syncthreads();
  XcdBarrier xb = xcd_barrier_post(p.bar, xst);
  phase0a(p, smem);
  if (p.bar == nullptr) grid.sync();
  xcd_barrier(xb);
  phase0b(p, smem);
  phase1(p, 0);
  xcd_barrier(xb);
  for (int l = 0; l < 2; l++) {
    for (int hf = 0; hf < 2; hf++) {
      if (hf == 0) {
        phase2(p, l, 0, smem);
        xcd_barrier(xb);
      }
      phase3(p, l, smem);
      xcd_barrier(xb);
      phase4(p, l, smem);
      xcd_barrier(xb);
      for (int it = obid(); it < (l == 0 ? 1056 : 1024); it += gridDim.x) mlstm_out_item(p, l, it, smem);
      xcd_barrier(xb);
      phase6(p, l, smem);
      xcd_barrier(xb);
      phase7(p, l, hf);
      if (hf == 0) {
        phase2(p, l, 1, smem);
        xcd_barrier(xb);
      }
    }
    if (l == 0) {
      xcd_barrier(xb);
      phase1(p, 1);
      xcd_barrier(xb);
    }
  }
}

extern "C" void kernel_launch(void* const* d_in, const int* in_sizes, int n_in, void* d_out, int out_size, void* d_ws,
                              size_t ws_size, hipStream_t stream) {
  static int grid_blocks = 0;
  if (grid_blocks == 0) {
    int dev = 0, cus = 0, per_cu = 0;
    hipGetDevice(&dev);
    hipDeviceGetAttribute(&cus, hipDeviceAttributeMultiprocessorCount, dev);
    if (hipFuncSetAttribute((const void*)mk_forward, hipFuncAttributeMaxDynamicSharedMemorySize, LDS_BYTES) != hipSuccess) {
      fprintf(stderr, "hipFuncSetAttribute failed\n");
    }
    if (hipOccupancyMaxActiveBlocksPerMultiprocessor(&per_cu, (const void*)mk_forward, 256, LDS_BYTES) != hipSuccess || per_cu < 1) {
      fprintf(stderr, "occupancy query failed (%d)\n", per_cu);
      per_cu = 1;
    }
    (void)hipGetLastError();
    if (per_cu > 2) per_cu = 2;
    grid_blocks = cus * per_cu;
  }
  Params p{};
  p.x = (const float*)d_in[0]; p.c = (const float*)d_in[1]; p.ctx = (const float*)d_in[2]; p.c_ctx = (const float*)d_in[3];
  p.w_mod = (const float*)d_in[4]; p.b_mod = (const float*)d_in[5]; p.g_pre = (const float*)d_in[6];
  p.g_post = (const float*)d_in[7]; p.w_in = (const float*)d_in[8]; p.b_gate = (const float*)d_in[9];
  p.g_hnorm = (const float*)d_in[10]; p.g_sgu = (const float*)d_in[11]; p.w_sp = (const float*)d_in[12];
  p.b_sp = (const float*)d_in[13]; p.w_fno = (const float*)d_in[14]; p.b_fno = (const float*)d_in[15];
  p.w_out = (const float*)d_in[16];
  p.out = (float*)d_out;
  size_t off = 0;
  unsigned char* ws = (unsigned char*)d_ws;
  auto take = [&](size_t bytes) -> void* {
    void* r = ws + off;
    off += (bytes + 255) & ~(size_t)255;
    return r;
  };
  p.wt_in = (bf*)take((size_t)2 * NPW * D * 2);
  p.wt_out = (bf*)take((size_t)2 * D * 2048 * 2);
  p.wsp = (bf*)take((size_t)2 * 4 * 128 * 128 * 2);
  p.m1 = (bf*)take(128 * 128 * 2);
  p.m2 = (bf*)take(128 * 256 * 2);
  p.mctx = (bf*)take(256 * 512 * 2);
  p.hN = (bf*)take((size_t)ROWS * D * 2);
  p.P = (bf*)take((size_t)57 * HROWS * 128 * 2);
  p.abuf = (bf*)take((size_t)2 * 64 * 2 * 128 * 512 * 2);
  p.ybuf = (bf*)take((size_t)HROWS * D * 2);
  p.cbuf = (bf*)take((size_t)2 * 256 * 512 * 2);
  p.mod = (float*)take(2 * 5 * 3072 * 4);
  p.tw = (float*)take(128 * 64 * 8);
  p.Q = (float*)take((size_t)2 * 4 * 128 * 256 * 4);
  p.gates = (float*)take((size_t)HROWS * 32 * 4);
  p.states = (bf*)take((size_t)32 * 66 * 8192 * 2);
  p.nbuf = (float*)take((size_t)32 * 66 * 64 * 4);
  p.scal = (float*)take(32 * 66 * 2 * 4);
  p.mstart = (float*)take(32 * 66 * 4);
  p.xc1 = (float*)take((size_t)1024 * 1024 * 4);
  p.bar = (unsigned*)take((size_t)XCD_BAR_WORDS * 4);
  if (off > ws_size) {
    fprintf(stderr, "workspace too small: need %zu have %zu\n", off, ws_size);
    return;
  }
  if (hipMemsetAsync(p.bar, 0, (size_t)XCD_BAR_WORDS * 4, stream) != hipSuccess) fprintf(stderr, "memset failed\n");
  void* args[] = {&p};
  hipError_t e = hipLaunchCooperativeKernel((const void*)mk_forward, dim3(grid_blocks), dim3(256), args, LDS_BYTES, stream);
  if (e != hipSuccess) fprintf(stderr, "cooperative launch failed: %s (grid %d)\n", hipGetErrorString(e), grid_blocks);
}
```

```cpp
#include <hip/hip_runtime.h>
#include <hip/hip_cooperative_groups.h>
#include <cstdio>
namespace cg = cooperative_groups;

typedef unsigned short bf;
typedef __attribute__((ext_vector_type(8))) short bf16x8;
typedef __attribute__((ext_vector_type(16))) float f32x16;

#define DEV __device__ __forceinline__

constexpr int D = 1024, TB = 8448, ROWS = 33792, HROWS = 16896;
constexpr int NP = 7200, NPW = 7296, NIN = 6688;
constexpr int CQ = 0, CK = 512, CV = 1024, CO = 2048, CZA = 3072, CU = 4096, CVS = 4608, CZB = 5120,
              CHR = 5632, CZC = 6144, CHI = 6656, CG = 7168;
constexpr int SRC_G = 2048, SRC_F = 5664;
constexpr int SSLOT = 8256;
constexpr float EPS = 1e-6f;
constexpr int BKP = 40;
constexpr int LDS_BYTES = 80896;
constexpr int OFF_SB = 36864, OFF_SB32 = 20480, OFF_SL = 40960, OFF_VEC = 75776;

struct Params {
  const float *x, *c, *ctx, *c_ctx, *w_mod, *b_mod, *g_pre, *g_post, *w_in, *b_gate, *g_hnorm, *g_sgu, *w_sp, *b_sp,
      *w_fno, *b_fno, *w_out;
  float* out;
  bf *wt_in, *wt_out, *wsp, *m1, *m2, *mctx, *hN, *P, *abuf, *ybuf, *cbuf, *states;
  float *mod, *tw, *Q, *gates, *nbuf, *scal, *mstart, *xc1;
  unsigned* bar;
};

typedef __attribute__((ext_vector_type(2))) __bf16 bf16x2_t;
typedef __attribute__((ext_vector_type(2))) float f32x2_t;
DEV unsigned pack2(float a, float b) {
  f32x2_t f = {a, b};
  bf16x2_t h = __builtin_convertvector(f, bf16x2_t);
  return __builtin_bit_cast(unsigned, h);
}
DEV bf f2bf(float f) { return (bf)(pack2(f, f) & 0xffffu); }
DEV float bf2f(bf h) { return __uint_as_float(((unsigned)h) << 16); }
DEV float lo2f(unsigned u) { return __uint_as_float(u << 16); }
DEV float hi2f(unsigned u) { return __uint_as_float(u & 0xffff0000u); }
DEV int otid() {
  int t = threadIdx.x;
  asm volatile("" : "+v"(t));
  return t;
}
DEV int obid() {
  int b = blockIdx.x;
  asm volatile("" : "+s"(b));
  return b;
}
DEV unsigned pidx(int row, int col) { return (unsigned)(((col >> 7) * HROWS + row) * 128 + (col & 127)); }
typedef __attribute__((ext_vector_type(4))) float f32x4v;
DEV float4 nt_load4(const float* p) {
  f32x4v v = __builtin_nontemporal_load((const f32x4v*)p);
  return make_float4(v[0], v[1], v[2], v[3]);
}
DEV void nt_store4(float* p, float4 o) {
  f32x4v v = {o.x, o.y, o.z, o.w};
  __builtin_nontemporal_store(v, (f32x4v*)p);
}
DEV float silu(float x) { return x / (1.f + __expf(-x)); }
DEV float sigm(float x) { return 1.f / (1.f + __expf(-x)); }
DEV float logsigmoid(float x) { return fminf(x, 0.f) - log1pf(__expf(-fabsf(x))); }

typedef __attribute__((ext_vector_type(4))) unsigned u32x4;
typedef __attribute__((ext_vector_type(4))) short s16x4;
DEV bf16x8 tr_frag(const bf* p, int ld) {
  typedef __attribute__((address_space(3))) s16x4 lds_s16x4;
  s16x4 t0 = __builtin_amdgcn_ds_read_tr16_b64_v4i16((lds_s16x4*)p);
  s16x4 t1 = __builtin_amdgcn_ds_read_tr16_b64_v4i16((lds_s16x4*)(p + 4 * ld));
  bf16x8 f = {t0[0], t0[1], t0[2], t0[3], t1[0], t1[1], t1[2], t1[3]};
  return f;
}
template <int BM, int BN, int BK, bool ATOK, bool BTOK, bool PF2 = false, class FA, class FB>
DEV void block_gemm(f32x16 (&acc)[BM / 64][BN / 64], FA getA, FB getB, int nkt, bf* sA, bf* sB, bool zero = true) {
  constexpr int MT = BM / 64, NTl = BN / 64, KV = BK / 8, NA = BM * KV / 256, NB = BN * KV / 256;
  constexpr int LDK = BK + 8;
  constexpr int LDAT = BM + 8, LDBT = BN + 8;
  constexpr int XBUFA = ATOK ? BK * LDAT : BM * LDK, XBUFB = BTOK ? BK * LDBT : BN * LDK;
  const int tid = otid(), lane = tid & 63, w = tid >> 6, wm = w >> 1, wn = w & 1;
  uint4 ra[NA], rb[NB];
  if (zero) {
#pragma unroll
    for (int i = 0; i < MT; i++)
#pragma unroll
      for (int j = 0; j < NTl; j++)
#pragma unroll
        for (int r = 0; r < 16; r++) acc[i][j][r] = 0.f;
  }

#define BG_FETCH(kt, RA, RB)                                                          \
  {                                                                                   \
    _Pragma("unroll") for (int i = 0; i < NA; i++) {                                  \
      int idx = tid + 256 * i;                                                        \
      if (ATOK) RA[i] = getA((kt), idx / (BM / 8), (idx % (BM / 8)) * 8);              \
      else RA[i] = getA((kt), idx / KV, (idx % KV) * 8);                              \
    }                                                                                 \
    _Pragma("unroll") for (int i = 0; i < NB; i++) {                                  \
      int idx = tid + 256 * i;                                                        \
      if (BTOK) RB[i] = getB((kt), idx / (BN / 8), (idx % (BN / 8)) * 8);              \
      else RB[i] = getB((kt), idx / KV, (idx % KV) * 8);                              \
    }                                                                                 \
  }
#define BG_STASH(buf, RA, RB)                                                         \
  {                                                                                   \
    _Pragma("unroll") for (int i = 0; i < NA; i++) {                                  \
      int idx = tid + 256 * i;                                                        \
      if (ATOK) *(uint4*)(sA + (buf) * XBUFA + (idx / (BM / 8)) * LDAT + (idx % (BM / 8)) * 8) = RA[i]; \
      else *(uint4*)(sA + (buf) * XBUFA + (idx / KV) * LDK + (idx % KV) * 8) = RA[i];  \
    }                                                                                 \
    _Pragma("unroll") for (int i = 0; i < NB; i++) {                                  \
      int idx = tid + 256 * i;                                                        \
      if (BTOK) *(uint4*)(sB + (buf) * XBUFB + (idx / (BN / 8)) * LDBT + (idx % (BN / 8)) * 8) = RB[i]; \
      else *(uint4*)(sB + (buf) * XBUFB + (idx / KV) * LDK + (idx % KV) * 8) = RB[i];  \
    }                                                                                 \
  }
#define BG_COMPUTE(buf)                                                               \
  _Pragma("unroll") for (int ks = 0; ks < BK / 16; ks++) {                            \
    bf16x8 a[MT], b[NTl];                                                             \
    _Pragma("unroll") for (int i = 0; i < MT; i++) {                                  \
      if (ATOK) {                                                                     \
        a[i] = tr_frag(sA + (buf) * XBUFA + (ks * 16 + (lane >> 5) * 8 + ((lane & 15) >> 2)) * LDAT + wm * (BM / 2) + i * 32 + \
                       ((lane >> 4) & 1) * 16 + (lane & 3) * 4, LDAT);                \
      } else {                                                                        \
        a[i] = *(const bf16x8*)(sA + (buf) * XBUFA + (wm * (BM / 2) + i * 32 + (lane & 31)) * LDK + ks * 16 + (lane >> 5) * 8); \
      }                                                                               \
    }                                                                                 \
    _Pragma("unroll") for (int j = 0; j < NTl; j++) {                                 \
      if (BTOK) {                                                                     \
        b[j] = tr_frag(sB + (buf) * XBUFB + (ks * 16 + (lane >> 5) * 8 + ((lane & 15) >> 2)) * LDBT + wn * (BN / 2) + j * 32 + \
                       ((lane >> 4) & 1) * 16 + (lane & 3) * 4, LDBT);                \
      } else {                                                                        \
        b[j] = *(const bf16x8*)(sB + (buf) * XBUFB + (wn * (BN / 2) + j * 32 + (lane & 31)) * LDK + ks * 16 + (lane >> 5) * 8); \
      }                                                                               \
    }                                                                                 \
    _Pragma("unroll") for (int i = 0; i < MT; i++)                                    \
      _Pragma("unroll") for (int j = 0; j < NTl; j++)                                 \
        acc[i][j] = __builtin_amdgcn_mfma_f32_32x32x16_bf16(a[i], b[j], acc[i][j], 0, 0, 0); \
    if (!ATOK && !BTOK) {                                                             \
      _Pragma("unroll") for (int q = 0; q < MT * NTl; q++) {                          \
        __builtin_amdgcn_sched_group_barrier(0x008, 1, 0);                            \
        __builtin_amdgcn_sched_group_barrier(0x100, 1, 0);                            \
      }                                                                               \
    }                                                                                 \
  }

  if (PF2) {
    uint4 ra2[NA], rb2[NB];
    BG_FETCH(0, ra, rb);
    BG_FETCH(1, ra2, rb2);
    BG_STASH(0, ra, rb);
    __syncthreads();
#pragma unroll 1
    for (int kt = 0; kt < nkt; kt += 2) {
      const int k2 = min(kt + 2, nkt - 1), k3 = min(kt + 3, nkt - 1);
      BG_FETCH(k2, ra, rb);
      BG_COMPUTE(0);
      BG_STASH(1, ra2, rb2);
      __syncthreads();
      BG_FETCH(k3, ra2, rb2);
      BG_COMPUTE(1);
      BG_STASH(0, ra, rb);
      __syncthreads();
    }
  } else {
    BG_FETCH(0, ra, rb);
    BG_STASH(0, ra, rb);
    __syncthreads();
#pragma unroll 1
    for (int kt = 0; kt < nkt; kt++) {
      const int buf = kt & 1;
      if (kt + 1 < nkt) BG_FETCH(kt + 1, ra, rb);
      BG_COMPUTE(buf);
      if (kt + 1 < nkt) BG_STASH(buf ^ 1, ra, rb);
      __syncthreads();
    }
  }
#undef BG_FETCH
#undef BG_STASH
#undef BG_COMPUTE
}

template <int BM, class FD>
DEV void store_tile_bf16(f32x16 (&acc)[BM / 64][2], bf* Cs, FD dst, int ncols_valid) {
  acc_foreach<BM, 128>(acc, [&](int row, int col, float v) { Cs[row * 136 + col] = f2bf(v); });
  __syncthreads();
  const int tid = otid();
#pragma unroll 4
  for (int i = 0; i < BM / 16; i++) {
    int idx = tid + 256 * i;
    int row = idx >> 4, c8 = (idx & 15) * 8;
    uint4 v = *(const uint4*)(Cs + row * 136 + c8);
    if (c8 < ncols_valid) *(uint4*)(dst(row) + c8) = v;
  }
  __syncthreads();
}

DEV uint4 scale8(uint4 q, float sc) {
  return make_uint4(pack2(lo2f(q.x) * sc, hi2f(q.x) * sc), pack2(lo2f(q.y) * sc, hi2f(q.y) * sc),
                    pack2(lo2f(q.z) * sc, hi2f(q.z) * sc), pack2(lo2f(q.w) * sc, hi2f(q.w) * sc));
}

template <int BM, int BN, class F>
DEV void acc_foreach(f32x16 (&acc)[BM / 64][BN / 64], F f) {
  const int tid_ = otid();
  const int lane = tid_ & 63, w = tid_ >> 6, wm = w >> 1, wn = w & 1;
#pragma unroll
  for (int i = 0; i < BM / 64; i++)
#pragma unroll
    for (int j = 0; j < BN / 64; j++)
#pragma unroll
      for (int r = 0; r < 16; r++) {
        int row = wm * (BM / 2) + i * 32 + (r & 3) + 8 * (r >> 2) + 4 * (lane >> 5);
        int col = wn * (BN / 2) + j * 32 + (lane & 31);
        f(row, col, acc[i][j][r]);
        if (r == 15) asm volatile("" ::: "memory");
      }
}

DEV void conv_tile(const float* __restrict__ src, int srcld, int sn0, int nvalid, bf* __restrict__ dst, int dstld, int n0, int k0,
                   float* tile) {
  const int tid = otid();
  {
    float4 v[4];
#pragma unroll
    for (int i = 0; i < 4; i++) {
      int idx = tid + 256 * i;
      int kk = idx >> 4, n4 = (idx & 15) * 4;
      v[i] = make_float4(0.f, 0.f, 0.f, 0.f);
      if (n4 < nvalid) v[i] = *(const float4*)(src + (size_t)(k0 + kk) * srcld + sn0 + n4);
    }
#pragma unroll
    for (int i = 0; i < 4; i++) {
      int idx = tid + 256 * i;
      int kk = idx >> 4, n4 = (idx & 15) * 4;
      tile[kk * 65 + n4] = v[i].x; tile[kk * 65 + n4 + 1] = v[i].y; tile[kk * 65 + n4 + 2] = v[i].z; tile[kk * 65 + n4 + 3] = v[i].w;
    }
  }
  __syncthreads();
#pragma unroll 4
  for (int i = 0; i < 16; i++) {
    int idx = tid + 256 * i;
    int nn = idx >> 6, kk = idx & 63;
    int n = n0 + nn;
    dst[(size_t)n * dstld + k0 + kk] = f2bf(tile[kk * 65 + nn]);
  }
  __syncthreads();
}

DEV void phase0a(const Params& p, unsigned char* smem) {
  const int tid = otid();
  float* fs = (float*)smem;
  for (int it = obid(); it < 2 * 114 * 16; it += gridDim.x) {
    int kt = it & 15, nt = (it >> 4) % 114, l = it / (114 * 16);
    const int n0 = nt * 64;
    int sn0 = n0, nvalid = 64;
    if (n0 < 2048) sn0 = n0;
    else if (n0 < CHR) sn0 = n0 + 32;
    else if (n0 < CZC) continue;
    else if (n0 < CHI) sn0 = n0 + 32;
    else if (n0 < CG) continue;
    else if (n0 == CG) { sn0 = SRC_G; nvalid = 32; }
    else { sn0 = 0; nvalid = 0; }
    conv_tile(p.w_in + (size_t)l * D * NIN, NIN, sn0, nvalid, p.wt_in + (size_t)l * NPW * D, D, n0, kt * 64, fs);
  }
  for (int it = obid(); it < 2 * 16 * 32; it += gridDim.x) {
    int kt = it & 31, nt = (it >> 5) & 15, l = it >> 9;
    conv_tile(p.w_out + (size_t)l * 2048 * D, D, nt * 64, 64, p.wt_out + (size_t)l * D * 2048, 2048, nt * 64, kt * 64, fs);
  }
  for (int it = obid(); it < 96; it += gridDim.x) {
    int l = it / 48, j0 = (it % 48) * 64;
    float* sc = fs;
    float* red = fs + 5 * 1024;
    for (int i = tid; i < 5 * 1024; i += 256) {
      int v = i >> 10, k = i & 1023;
      float cv = (v < 4) ? p.c[v * D + k] : p.c_ctx[k];
      sc[i] = silu(cv);
    }
    __syncthreads();
    int col = tid & 63, ks = tid >> 6;
    float a0 = 0, a1 = 0, a2 = 0, a3 = 0, a4 = 0;
    const float* wp = p.w_mod + (size_t)l * D * 3072 + j0 + col;
#pragma unroll 16
    for (int k = ks * 256; k < ks * 256 + 256; k++) {
      float wv = wp[(size_t)k * 3072];
      a0 += sc[k] * wv; a1 += sc[1024 + k] * wv; a2 += sc[2048 + k] * wv; a3 += sc[3072 + k] * wv; a4 += sc[4096 + k] * wv;
    }
    red[(ks * 5 + 0) * 64 + col] = a0; red[(ks * 5 + 1) * 64 + col] = a1; red[(ks * 5 + 2) * 64 + col] = a2;
    red[(ks * 5 + 3) * 64 + col] = a3; red[(ks * 5 + 4) * 64 + col] = a4;
    __syncthreads();
    for (int i = tid; i < 5 * 64; i += 256) {
      int v = i >> 6, cc = i & 63;
      float s = red[(0 * 5 + v) * 64 + cc] + red[(1 * 5 + v) * 64 + cc] + red[(2 * 5 + v) * 64 + cc] + red[(3 * 5 + v) * 64 + cc];
      p.mod[(l * 5 + v) * 3072 + j0 + cc] = s + p.b_mod[l * 3072 + j0 + cc];
    }
    __syncthreads();
  }
  const int gtid = obid() * 256 + tid, gsz = gridDim.x * 256;
  for (int i = gtid; i < 2 * 4 * 128 * 128; i += gsz) p.wsp[i] = f2bf(p.w_sp[i]);
  for (int i = gtid; i < 128 * 128; i += gsz) {
    int m = i >> 7, k = i & 127;
    int wmm = m >> 6, rip = (m >> 5) & 1, k1 = wmm * 32 + (m & 31);
    int ri = k >> 6, t1 = k & 63;
    float s, c;
    sincospif((float)((k1 * t1) & 63) / 32.f, &s, &c);
    float v = rip == 0 ? (ri == 0 ? c : s) : (ri == 0 ? -s : c);
    p.m1[i] = f2bf(v);
  }
  for (int i = gtid; i < 128 * 256; i += gsz) {
    int k2 = i >> 8, k = i & 255;
    int ri = k >> 7, t2 = k & 127;
    float s, c;
    sincospif((float)((t2 * k2) & 127) / 64.f, &s, &c);
    p.m2[i] = f2bf(ri == 0 ? c : s);
  }
  for (int i = gtid; i < 256 * 512; i += gsz) {
    int tp = i >> 9, k = i & 511;
    int ri = k >> 8, t = k & 255;
    float s, c;
    sincospif((float)((t * tp) & 255) / 128.f, &s, &c);
    p.mctx[i] = f2bf(ri == 0 ? c : s);
  }
  for (int i = gtid; i < 128 * 64; i += gsz) {
    int t2 = i >> 6, k1 = i & 63;
    float s, c;
    sincospif((float)(t2 * k1) / 4096.f, &s, &c);
    p.tw[2 * i] = c;
    p.tw[2 * i + 1] = s;
  }
  __syncthreads();
  if (tid < 128) {
    float s, co;
    sincospif((float)tid / 64.f, &s, &co);
    fs[tid] = co;
    fs[128 + tid] = -s;
  }
  __syncthreads();
  for (int i = gtid; i < 2 * 4 * 128 * 256; i += gsz) {
    int d = i & 127, ri = (i >> 7) & 1, c = (i >> 8) & 127, lg = i >> 15;
    const float* wf = p.w_fno + (size_t)lg * 128 * 128 + d;
    const float* tr = fs + ri * 128;
    float acc = 0.f;
#pragma unroll 8
    for (int cp = 0; cp < 128; cp++) acc += tr[(c * cp) & 127] * wf[cp * 128];
    p.Q[i] = acc * 0.08838834764831845f;
  }
}

DEV void phase0b(const Params& p, unsigned char* smem) {
  const int tid = otid();
  float* wl = (float*)smem;
  for (int it = obid(); it < 256; it += gridDim.x) {
    int l = it >> 7, k0 = (it & 127) * 8;
    const float* wsrc = p.w_in + (size_t)l * D * NIN + (size_t)k0 * NIN + SRC_F;
    {
      float4 wv4[4];
#pragma unroll
      for (int i = 0; i < 4; i++) {
        int idx = tid + 256 * i;
        int kk = idx >> 7, f4 = (idx & 127) * 4;
        wv4[i] = *(const float4*)(wsrc + (size_t)kk * NIN + f4);
      }
#pragma unroll
      for (int i = 0; i < 4; i++) {
        int idx = tid + 256 * i;
        int kk = idx >> 7, f4 = (idx & 127) * 4;
        wl[(f4 + 0) * 8 + kk] = wv4[i].x; wl[(f4 + 1) * 8 + kk] = wv4[i].y; wl[(f4 + 2) * 8 + kk] = wv4[i].z; wl[(f4 + 3) * 8 + kk] = wv4[i].w;
      }
    }
    __syncthreads();
    for (int jj = 0; jj < 4; jj++) {
      int np = tid + 256 * jj;
      int d = np & 127, g = (np >> 7) & 3, ri = np >> 9;
      float acc[8];
#pragma unroll
      for (int kk = 0; kk < 8; kk++) acc[kk] = 0.f;
      const float* qp = p.Q + ((size_t)(l * 4 + g) * 128) * 256 + ri * 128 + d;
      const float* wp = wl + g * 128 * 8;
#pragma unroll 16
      for (int c = 0; c < 128; c++) {
        float qv = qp[c * 256];
        float4 w0 = *(const float4*)(wp + c * 8), w1 = *(const float4*)(wp + c * 8 + 4);
        acc[0] += w0.x * qv; acc[1] += w0.y * qv; acc[2] += w0.z * qv; acc[3] += w0.w * qv;
        acc[4] += w1.x * qv; acc[5] += w1.y * qv; acc[6] += w1.z * qv; acc[7] += w1.w * qv;
      }
      int n = (ri ? CHI : CHR) + g * 128 + d;
      uint4 o = make_uint4(pack2(acc[0], acc[1]), pack2(acc[2], acc[3]), pack2(acc[4], acc[5]), pack2(acc[6], acc[7]));
      *(uint4*)(p.wt_in + ((size_t)l * NPW + n) * D + k0) = o;
    }
    __syncthreads();
  }
}

DEV void phase1(const Params& p, int l) {
  const int lane = otid() & 63, w = otid() >> 6;
  for (int r = obid() * 4 + w; r < ROWS; r += gridDim.x * 4) {
    int b = r / TB, j = r % TB;
    const float* xin;
    int mv;
    if (j < 256) {
      xin = (l == 0 ? p.ctx : p.xc1) + ((size_t)b * 256 + j) * D;
      mv = 4;
    } else {
      xin = (l == 0 ? p.x : p.out) + ((size_t)b * 8192 + (j - 256)) * D;
      mv = b;
    }
    const float* md = p.mod + (size_t)(l * 5 + mv) * 3072;
    float4 v[4];
    float ss = 0.f;
#pragma unroll
    for (int i = 0; i < 4; i++) {
      v[i] = nt_load4(xin + lane * 4 + 256 * i);
      ss += v[i].x * v[i].x + v[i].y * v[i].y + v[i].z * v[i].z + v[i].w * v[i].w;
    }
#pragma unroll
    for (int off = 32; off; off >>= 1) ss += __shfl_xor(ss, off);
    float rstd = rsqrtf(ss * (1.f / 1024.f) + EPS);
#pragma unroll
    for (int i = 0; i < 4; i++) {
      int col = lane * 4 + 256 * i;
      float4 g = *(const float4*)(p.g_pre + l * D + col);
      float4 sh = *(const float4*)(md + col);
      float4 sc = *(const float4*)(md + 1024 + col);
      float o0 = v[i].x * rstd * g.x * (1.f + sc.x) + sh.x;
      float o1 = v[i].y * rstd * g.y * (1.f + sc.y) + sh.y;
      float o2 = v[i].z * rstd * g.z * (1.f + sc.z) + sh.z;
      float o3 = v[i].w * rstd * g.w * (1.f + sc.w) + sh.w;
      *(uint2*)(p.hN + (size_t)r * D + col) = make_uint2(pack2(o0, o1), pack2(o2, o3));
    }
  }
}

DEV void phase2(const Params& p, int l, int hf, unsigned char* smem) {
  bf* sA = (bf*)smem;
  bf* sB = (bf*)(smem + 40960);
  const int bid = obid();
  const int nxb = gridDim.x >> 3, xcd = bid & 7, lb = bid >> 3;
  const int per = (66 * 57 + 7) / 8;
  const int tend = min((xcd + 1) * per, 66 * 57);
  for (int t = xcd * per + lb; t < tend; t += nxb) {
    int ms, rem, rows_in;
    if (t < 8 * 8 * 57) { ms = t / 456; rem = t - ms * 456; rows_in = 8; }
    else { ms = 8; rem = t - 8 * 456; rows_in = 2; }
    int ns = rem / (rows_in * 8);
    if (ns > 7) ns = 7;
    int r2 = rem - ns * rows_in * 8;
    int mt = ms * 8 + (r2 % rows_in), nt = ns * 8 + (r2 / rows_in);
    const bf* A = p.hN + ((size_t)hf * HROWS + mt * 256) * D;
    const bf* B = p.wt_in + ((size_t)l * NPW + nt * 128) * D;
    f32x16 acc[4][2];
    auto gA = [&](int kt, int r, int ko) -> uint4 { return *(const uint4*)(A + (unsigned)(r * D + kt * 32 + ko)); };
    auto gB = [&](int kt, int r, int ko) -> uint4 { return *(const uint4*)(B + (unsigned)(r * D + kt * 32 + ko)); };
    block_gemm<256, 128, 32, false, false, true>(acc, gA, gB, 32, sA, sB);
    if (nt == CG / 128) {
      acc_foreach<256, 128>(acc, [&](int row, int col, float v) {
        if (col < 32) p.gates[(unsigned)((mt * 256 + row) * 32 + col)] = v + p.b_gate[l * 32 + col];
      });
    }
    store_tile_bf16<256>(acc, (bf*)smem, [&](int row) -> bf* { return p.P + pidx(mt * 256 + row, nt * 128); }, min(128, NP - nt * 128));
  }
}

DEV void gate_prep(const float* __restrict__ gch, int h, float* vec, bool want_w) {
  const int tid = otid(), lane = tid & 63, w = tid >> 6;
  if (w < 2) {
    const int d = w;
    int p0 = 2 * lane, p1 = p0 + 1;
    int i0 = d ? 127 - p0 : p0, i1 = d ? 127 - p1 : p1;
    float ig0 = gch[i0 * 32 + (2 * d) * 8 + h], ig1 = gch[i1 * 32 + (2 * d) * 8 + h];
    float lf0 = logsigmoid(gch[i0 * 32 + (2 * d + 1) * 8 + h]), lf1 = logsigmoid(gch[i1 * 32 + (2 * d + 1) * 8 + h]);
    float incl = lf0 + lf1;
#pragma unroll
    for (int off = 1; off < 64; off <<= 1) {
      float t = __shfl_up(incl, off);
      if (lane >= off) incl += t;
    }
    float b1 = incl, b0 = incl - lf1;
    float a0 = ig0 - b0, a1 = ig1 - b1;
    float mincl = fmaxf(a0, a1);
#pragma unroll
    for (int off = 1; off < 64; off <<= 1) {
      float t = __shfl_up(mincl, off);
      if (lane >= off) mincl = fmaxf(mincl, t);
    }
    float prev = __shfl_up(mincl, 1);
    float pm0 = lane ? fmaxf(prev, a0) : a0, pm1 = mincl;
    float tot = __shfl(b1, 63);
    vec[d * 128 + i0] = ig0;
    vec[d * 128 + i1] = ig1;
    vec[256 + d * 128 + i0] = b0;
    vec[256 + d * 128 + i1] = b1;
    if (want_w) {
      float wl0 = tot - b0 + ig0, wl1 = tot - b1 + ig1;
      float mx = fmaxf(wl0, wl1);
#pragma unroll
      for (int off = 32; off; off >>= 1) mx = fmaxf(mx, __shfl_xor(mx, off));
      vec[512 + d * 128 + i0] = __expf(wl0 - mx);
      vec[512 + d * 128 + i1] = __expf(wl1 - mx);
      if (lane == 0) {
        vec[1152 + d * 2] = tot;
        vec[1152 + d * 2 + 1] = mx;
      }
    } else {
      vec[512 + d * 128 + i0] = pm0;
      vec[512 + d * 128 + i1] = pm1;
      if (lane == 0) vec[1152 + d * 2] = tot;
    }
  }
  __syncthreads();
}

DEV void mlstm_dc_item(const Params& p, int it, unsigned char* smem) {
  bf* sA = (bf*)smem;
  bf* sB = (bf*)(smem + OFF_SB);
  float* vec = (float*)(smem + OFF_VEC);
  const int tid = otid();
  int j = it % 66, h = (it / 66) & 7, bl = it / 528;
  size_t base = (size_t)bl * TB + j * 128;
  gate_prep(p.gates + base * 32, h, vec, true);
  const bf* Pb = p.P;
  const int rb = (int)base;
  for (int d = 0; d < 2; d++) {
    int sid = (bl * 8 + h) * 2 + d;
    bf* slot = p.states + ((size_t)sid * 66 + j) * 8192;
    float* nslot = p.nbuf + ((size_t)sid * 66 + j) * 64;
    const float* wv = vec + 512 + d * 128;
    f32x16 acc[1][2];
    auto gA = [&](int kt, int to, int c) -> uint4 {
      int tok = kt * 64 + to;
      return *(const uint4*)(Pb + pidx(rb + tok, CK + h * 64 + c));
    };
    auto gB = [&](int kt, int to, int c) -> uint4 {
      int tok = kt * 64 + to;
      return scale8(*(const uint4*)(Pb + pidx(rb + tok, CV + h * 128 + c)), wv[tok]);
    };
    block_gemm<64, 128, 64, true, true, true>(acc, gA, gB, 2, sA, sB);
    store_tile_bf16<64>(acc, (bf*)smem, [&](int row) -> bf* { return slot + row * 128; }, 128);
    {
      float* red = vec + 768;
      int dk = tid & 63, part = tid >> 6;
      float sacc = 0.f;
#pragma unroll 8
      for (int t = part * 32; t < part * 32 + 32; t++) sacc += wv[t] * bf2f(Pb[pidx(rb + t, CK + h * 64 + dk)]);
      red[part * 64 + dk] = sacc;
      __syncthreads();
      if (tid < 64) nslot[tid] = red[tid] + red[64 + tid] + red[128 + tid] + red[192 + tid];
    }
    if (tid == 0) {
      p.scal[(sid * 66 + j) * 2] = vec[1152 + d * 2];
      p.scal[(sid * 66 + j) * 2 + 1] = vec[1152 + d * 2 + 1];
    }
  }
  __syncthreads();
}

DEV void sgu_item(const Params& p, int l, int it, unsigned char* smem) {
  bf* sA = (bf*)smem;
  bf* sB = (bf*)(smem + OFF_SB);
  float* rstd = (float*)(smem + OFF_VEC);
  const int tid = otid();
  int g = it & 3, j = (it >> 2) % 66, bl = it / 264;
  size_t base = (size_t)bl * TB + j * 128;
  bf* Pb = p.P;
  const int rb = (int)base;
  {
    int t = tid >> 1, hh = tid & 1;
    float ss = 0.f;
    for (int i = 0; i < 32; i++) {
      uint4 u = *(const uint4*)(Pb + pidx(rb + t, CVS + hh * 256 + i * 8));
      float a;
      a = lo2f(u.x); ss += a * a; a = hi2f(u.x); ss += a * a;
      a = lo2f(u.y); ss += a * a; a = hi2f(u.y); ss += a * a;
      a = lo2f(u.z); ss += a * a; a = hi2f(u.z); ss += a * a;
      a = lo2f(u.w); ss += a * a; a = hi2f(u.w); ss += a * a;
    }
    ss += __shfl_xor(ss, 1);
    if (hh == 0) rstd[t] = rsqrtf(ss * (1.f / 512.f) + EPS);
  }
  __syncthreads();
  const bf* W = p.wsp + (size_t)(l * 4 + g) * 128 * 128;
  const float* gs = p.g_sgu + l * 512 + g * 128;
  f32x16 acc[2][2];
  auto gA = [&](int kt, int r, int ko) -> uint4 { return *(const uint4*)(W + r * 128 + kt * 64 + ko); };
  auto gB = [&](int kt, int to, int c) -> uint4 {
    int tok = kt * 64 + to;
    return scale8(*(const uint4*)(Pb + pidx(rb + tok, CVS + g * 128 + c)), rstd[tok]);
  };
  block_gemm<128, 128, 64, false, true, true>(acc, gA, gB, 2, sA, sB);
  const float* bs = p.b_sp + (size_t)(l * 4 + g) * 128;
  float* Hs = (float*)smem;
  acc_foreach<128, 128>(acc, [&](int t, int c, float v) { Hs[t * 132 + c] = v; });
  __syncthreads();
  {
    const int t = tid >> 1, hh = tid & 1;
    const float* hrow = Hs + t * 132 + hh * 64;
    const float* gp = gs + hh * 64;
    const float bt = bs[t];
#pragma unroll 2
    for (int i = 0; i < 8; i++) {
      bf* up = Pb + pidx(rb + t, CU + g * 128 + hh * 64 + i * 8);
      uint4 uu = *(const uint4*)up;
      uint4 uz = *(const uint4*)(Pb + pidx(rb + t, CZB + g * 128 + hh * 64 + i * 8));
      float4 h0 = *(const float4*)(hrow + i * 8), h1 = *(const float4*)(hrow + i * 8 + 4);
      float4 g0 = *(const float4*)(gp + i * 8), g1 = *(const float4*)(gp + i * 8 + 4);
      float y0 = lo2f(uu.x) * (h0.x * g0.x + bt) * silu(lo2f(uz.x));
      float y1 = hi2f(uu.x) * (h0.y * g0.y + bt) * silu(hi2f(uz.x));
      float y2 = lo2f(uu.y) * (h0.z * g0.z + bt) * silu(lo2f(uz.y));
      float y3 = hi2f(uu.y) * (h0.w * g0.w + bt) * silu(hi2f(uz.y));
      float y4 = lo2f(uu.z) * (h1.x * g1.x + bt) * silu(lo2f(uz.z));
      float y5 = hi2f(uu.z) * (h1.y * g1.y + bt) * silu(hi2f(uz.z));
      float y6 = lo2f(uu.w) * (h1.z * g1.z + bt) * silu(lo2f(uz.w));
      float y7 = hi2f(uu.w) * (h1.w * g1.w + bt) * silu(hi2f(uz.w));
      *(uint4*)up = make_uint4(pack2(y0, y1), pack2(y2, y3), pack2(y4, y5), pack2(y6, y7));
    }
  }
  __syncthreads();
}

DEV void fourA_item(const Params& p, int it, unsigned char* smem) {
  bf* sA = (bf*)smem;
  bf* sB = (bf*)(smem + OFF_SB);
  int cht = it & 3, t2 = (it >> 2) & 127, bl = it >> 9;
  const bf* Pb = p.P;
  const int rb = bl * TB + 256 + t2;
  f32x16 acc[2][2];
  auto gA = [&](int kt, int r, int ko) -> uint4 { return *(const uint4*)(p.m1 + r * 128 + kt * 64 + ko); };
  auto gB = [&](int kt, int to, int c) -> uint4 {
    int ri = kt, t1 = to;
    return *(const uint4*)(Pb + pidx(rb + t1 * 128, (ri ? CHI : CHR) + cht * 128 + c));
  };
  block_gemm<128, 128, 64, false, true, true>(acc, gA, gB, 2, sA, sB);
  float* Ha = (float*)smem;
  acc_foreach<128, 128>(acc, [&](int m, int c, float v) { Ha[m * 132 + c] = v; });
  __syncthreads();
  {
    const int tid = otid();
    const int k1 = tid >> 2, cq = (tid & 3) * 32;
    const float* ar = Ha + ((k1 >> 5) * 64 + (k1 & 31)) * 132 + cq;
    const float* ai = ar + 32 * 132;
    const float c = p.tw[(t2 * 64 + k1) * 2], sn = p.tw[(t2 * 64 + k1) * 2 + 1];
    bf* ore = p.abuf + ((((((size_t)bl * 64 + k1) * 4 + cht) * 2) * 128 + t2) * 128) + cq;
    bf* oim = ore + (size_t)128 * 128;
#pragma unroll
    for (int i = 0; i < 4; i++) {
      float4 r0 = *(const float4*)(ar + i * 8), r1 = *(const float4*)(ar + i * 8 + 4);
      float4 i0 = *(const float4*)(ai + i * 8), i1 = *(const float4*)(ai + i * 8 + 4);
      *(uint4*)(ore + i * 8) = make_uint4(pack2(r0.x * c + i0.x * sn, r0.y * c + i0.y * sn), pack2(r0.z * c + i0.z * sn, r0.w * c + i0.w * sn),
                                          pack2(r1.x * c + i1.x * sn, r1.y * c + i1.y * sn), pack2(r1.z * c + i1.z * sn, r1.w * c + i1.w * sn));
      *(uint4*)(oim + i * 8) = make_uint4(pack2(i0.x * c - r0.x * sn, i0.y * c - r0.y * sn), pack2(i0.z * c - r0.z * sn, i0.w * c - r0.w * sn),
                                          pack2(i1.x * c - r1.x * sn, i1.y * c - r1.y * sn), pack2(i1.z * c - r1.z * sn, i1.w * c - r1.w * sn));
    }
  }
  __syncthreads();
}

DEV void fourCtx_item(const Params& p, int l, int it, unsigned char* smem) {
  bf* sA = (bf*)smem;
  bf* sB = (bf*)(smem + OFF_SB);
  int mt = it & 1, g = (it >> 1) & 3, bl = it >> 3;
  const bf* Pb = p.P;
  const int rb = bl * TB;
  f32x16 acc[2][2];
  auto gA = [&](int kt, int r, int ko) -> uint4 { return *(const uint4*)(p.mctx + (mt * 128 + r) * 512 + kt * 64 + ko); };
  auto gB = [&](int kt, int to, int c) -> uint4 {
    int ri = kt >> 2, t = (kt & 3) * 64 + to;
    return *(const uint4*)(Pb + pidx(rb + t, (ri ? CHI : CHR) + g * 128 + c));
  };
  block_gemm<128, 128, 64, false, true, true>(acc, gA, gB, 8, sA, sB);
  float* Hs = (float*)smem;
  acc_foreach<128, 128>(acc, [&](int tl, int d, float v) { Hs[tl * 132 + d] = v; });
  __syncthreads();
  {
    const int tid = otid();
    const int tl = tid >> 1, hh = tid & 1;
    const int tp = mt * 128 + tl;
    const float* hrow = Hs + tl * 132 + hh * 64;
    const float* bp = p.b_fno + l * 512 + g * 128 + hh * 64;
    bf* op = p.cbuf + ((size_t)bl * 256 + tp) * 512 + g * 128 + hh * 64;
#pragma unroll 2
    for (int i = 0; i < 8; i++) {
      uint4 uz = *(const uint4*)(Pb + pidx(rb + tp, CZC + g * 128 + hh * 64 + i * 8));
      float4 h0 = *(const float4*)(hrow + i * 8), h1 = *(const float4*)(hrow + i * 8 + 4);
      float4 b0 = *(const float4*)(bp + i * 8), b1 = *(const float4*)(bp + i * 8 + 4);
      float y0 = (h0.x * 0.0625f + b0.x) * silu(lo2f(uz.x)), y1 = (h0.y * 0.0625f + b0.y) * silu(hi2f(uz.x));
      float y2 = (h0.z * 0.0625f + b0.z) * silu(lo2f(uz.y)), y3 = (h0.w * 0.0625f + b0.w) * silu(hi2f(uz.y));
      float y4 = (h1.x * 0.0625f + b1.x) * silu(lo2f(uz.z)), y5 = (h1.y * 0.0625f + b1.y) * silu(hi2f(uz.z));
      float y6 = (h1.z * 0.0625f + b1.z) * silu(lo2f(uz.w)), y7 = (h1.w * 0.0625f + b1.w) * silu(hi2f(uz.w));
      *(uint4*)(op + i * 8) = make_uint4(pack2(y0, y1), pack2(y2, y3), pack2(y4, y5), pack2(y6, y7));
    }
  }
  __syncthreads();
}

DEV void phase3(const Params& p, int l, unsigned char* smem) {
  const int n0 = 1056, n1 = n0 + 528, n2 = n1 + 1024, n3 = n2 + 16;
  for (int it = obid(); it < n3; it += gridDim.x) {
    if (it < n0) mlstm_dc_item(p, it, smem);
    else if (it < n1) sgu_item(p, l, it - n0, smem);
    else if (it < n2) fourA_item(p, it - n1, smem);
    else fourCtx_item(p, l, it - n2, smem);
  }
}

DEV int chunk_at(int d, int pp) { return d ? (pp == 0 ? 1 : (pp == 1 ? 0 : 67 - pp)) : pp; }
DEV void scan_item(const Params& p, int it, unsigned char* smem) {
  float* tab = (float*)(smem + OFF_VEC);
  const int tid = otid();
  int eb = it & 15, sid = it >> 4;
  int d = sid & 1;
  if (tid < 66) {
    int j = chunk_at(d, tid);
    tab[256 + tid] = p.scal[(sid * 66 + j) * 2];
    tab[384 + tid] = p.scal[(sid * 66 + j) * 2 + 1];
  }
  __syncthreads();
  if (tid == 0) {
    float m = 0.f;
    for (int pp = 0; pp < 66; pp++) {
      float bl_ = tab[256 + pp], ml = tab[384 + pp];
      float mn = fmaxf(bl_ + m, ml);
      tab[pp] = __expf(bl_ + m - mn);
      tab[128 + pp] = __expf(ml - mn);
      if (eb == 0) p.mstart[sid * 66 + chunk_at(d, pp)] = m;
      m = mn;
    }
  }
  __syncthreads();
  {
    float v0 = 0.f, v1 = 0.f;
    unsigned* basep = (unsigned*)(p.states + (size_t)sid * 66 * 8192) + eb * 256 + tid;
#pragma unroll 1
    for (int pb = 0; pb < 66; pb += 33) {
      unsigned dv[33];
#pragma unroll
      for (int u = 0; u < 33; u++) dv[u] = basep[(size_t)chunk_at(d, pb + u) * 4096];
#pragma unroll
      for (int u = 0; u < 33; u++) {
        basep[(size_t)chunk_at(d, pb + u) * 4096] = pack2(v0, v1);
        float de = tab[pb + u], sc = tab[128 + pb + u];
        v0 = de * v0 + sc * lo2f(dv[u]);
        v1 = de * v1 + sc * hi2f(dv[u]);
      }
    }
  }
  if (eb == 0 && tid < 64) {
    float val = 0.f;
    float* basep = p.nbuf + (size_t)sid * 66 * 64 + tid;
#pragma unroll 1
    for (int pb = 0; pb < 66; pb += 33) {
      float dv[33];
#pragma unroll
      for (int u = 0; u < 33; u++) dv[u] = basep[chunk_at(d, pb + u) * 64];
#pragma unroll
      for (int u = 0; u < 33; u++) {
        basep[chunk_at(d, pb + u) * 64] = val;
        val = tab[pb + u] * val + tab[128 + pb + u] * dv[u];
      }
    }
  }
  __syncthreads();
}

DEV void fourC_item(const Params& p, int l, int it, unsigned char* smem) {
  bf* sA = (bf*)smem;
  bf* sB = (bf*)(smem + OFF_SB);
  int g = it & 3, k1 = (it >> 2) & 63, bl = it >> 8;
  const bf* Ab = p.abuf + ((((size_t)bl * 64 + k1) * 4 + g) * 2) * 128 * 128;
  f32x16 acc[2][2];
  auto gA = [&](int kt, int r, int ko) -> uint4 { return *(const uint4*)(p.m2 + r * 256 + kt * 64 + ko); };
  auto gB = [&](int kt, int to, int c) -> uint4 {
    int kk = kt * 64 + to;
    return *(const uint4*)(Ab + (unsigned)(kk * 128 + c));
  };
  block_gemm<128, 128, 64, false, true, true>(acc, gA, gB, 4, sA, sB);
  bf* Pb = p.P;
  const int rb = bl * TB + 256;
  float* Hs = (float*)smem;
  acc_foreach<128, 128>(acc, [&](int k2, int d, float v) { Hs[k2 * 132 + d] = v; });
  __syncthreads();
  {
    const int tid = otid();
    const int k2 = tid >> 1, hh = tid & 1;
    const int tp = k1 + 64 * k2;
    const float* hrow = Hs + k2 * 132 + hh * 64;
    const float* bp = p.b_fno + l * 512 + g * 128 + hh * 64;
    const float sc = 0.011048543456039806f;
#pragma unroll 2
    for (int i = 0; i < 8; i++) {
      uint4 uz = *(const uint4*)(Pb + pidx(rb + tp, CZC + g * 128 + hh * 64 + i * 8));
      bf* op = Pb + pidx(rb + tp, CHR + g * 128 + hh * 64 + i * 8);
      float4 h0 = *(const float4*)(hrow + i * 8), h1 = *(const float4*)(hrow + i * 8 + 4);
      float4 b0 = *(const float4*)(bp + i * 8), b1 = *(const float4*)(bp + i * 8 + 4);
      float y0 = (h0.x * sc + b0.x) * silu(lo2f(uz.x)), y1 = (h0.y * sc + b0.y) * silu(hi2f(uz.x));
      float y2 = (h0.z * sc + b0.z) * silu(lo2f(uz.y)), y3 = (h0.w * sc + b0.w) * silu(hi2f(uz.y));
      float y4 = (h1.x * sc + b1.x) * silu(lo2f(uz.z)), y5 = (h1.y * sc + b1.y) * silu(hi2f(uz.z));
      float y6 = (h1.z * sc + b1.z) * silu(lo2f(uz.w)), y7 = (h1.w * sc + b1.w) * silu(hi2f(uz.w));
      *(uint4*)op = make_uint4(pack2(y0, y1), pack2(y2, y3), pack2(y4, y5), pack2(y6, y7));
    }
  }
  __syncthreads();
}

DEV void phase4(const Params& p, int l, unsigned char* smem) {
  const int n0 = 512, n1 = n0 + 32 * 16;
  for (int it = obid(); it < n1; it += gridDim.x) {
    if (it < n0) fourC_item(p, l, it, smem);
    else scan_item(p, it - n0, smem);
  }
  for (int i = obid() * 256 + otid(); i < 2 * 256 * 512; i += gridDim.x * 256) {
    int c = i & 511, t = (i >> 9) & 255, bl = i >> 17;
    p.P[pidx(bl * TB + t, CHR + c)] = p.cbuf[i];
  }
}

DEV void mlstm_out_item(const Params& p, int l, int it, unsigned char* smem) {
  bf* sA = (bf*)smem;
  bf* sB = (bf*)(smem + OFF_SB32);
  bf* Sl = (bf*)(smem + OFF_SL);
  float* vec = (float*)(smem + OFF_VEC);
  float* mrow = vec + 768;
  float* winter = vec + 896;
  float* dinv = vec + 1024;
  float* nst = vec + 1160;
  const int tid = otid(), lane = tid & 63, w = tid >> 6, wm = w >> 1, wn = w & 1;
  int j, h, bl;
  if (l == 0) { j = it % 66; h = (it / 66) & 7; bl = it / 528; }
  else { j = 2 + (it & 63); h = (it >> 6) & 7; bl = it >> 9; }
  size_t base = (size_t)bl * TB + j * 128;
  gate_prep(p.gates + base * 32, h, vec, false);
  bf* Pb = p.P;
  const int rb = (int)base;
  f32x16 acch[2][2];
  for (int d = 0; d < 2; d++) {
    int sid = (bl * 8 + h) * 2 + d;
    const bf* slot = p.states + ((size_t)sid * 66 + j) * 8192;
    const float* nslot = p.nbuf + ((size_t)sid * 66 + j) * 64;
    const float* igv = vec + d * 128;
    const float* bv = vec + 256 + d * 128;
    const float* pmv = vec + 512 + d * 128;
    float ms = p.mstart[sid * 66 + j];
    if (tid < 128) {
      float inter = bv[tid] + ms;
      float mr = fmaxf(inter, bv[tid] + pmv[tid]);
      mrow[tid] = mr;
      winter[tid] = __expf(inter - mr);
    } else if (tid < 192) {
      nst[tid - 128] = nslot[tid - 128];
    }
    __syncthreads();
    {
      f32x16 acc[2][2];
      auto gA = [&](int kt, int r, int ko) -> uint4 { return *(const uint4*)(Pb + pidx(rb + r, CQ + h * 64 + ko)); };
      auto gB = [&](int kt, int r, int ko) -> uint4 { return *(const uint4*)(Pb + pidx(rb + r, CK + h * 64 + ko)); };
      block_gemm<128, 128, 64, false, false>(acc, gA, gB, 1, sA, sB);
      acc_foreach<128, 128>(acc, [&](int t, int s, float v) { Sl[t * 136 + s] = f2bf(v); });
    }
    __syncthreads();
#pragma unroll 1
    for (int i = 0; i < 8; i++) {
      int idx = tid + 256 * i;
      int t = idx >> 4, s0 = (idx & 15) * 8;
      uint4 u = *(const uint4*)(Sl + t * 136 + s0);
      float rowc = bv[t] - mrow[t];
      float4 b0 = *(const float4*)(bv + s0), b1 = *(const float4*)(bv + s0 + 4);
      float4 g0 = *(const float4*)(igv + s0), g1 = *(const float4*)(igv + s0 + 4);
      float e[8];
      e[0] = lo2f(u.x) * __expf(rowc - b0.x + g0.x); e[1] = hi2f(u.x) * __expf(rowc - b0.y + g0.y);
      e[2] = lo2f(u.y) * __expf(rowc - b0.z + g0.z); e[3] = hi2f(u.y) * __expf(rowc - b0.w + g0.w);
      e[4] = lo2f(u.z) * __expf(rowc - b1.x + g1.x); e[5] = hi2f(u.z) * __expf(rowc - b1.y + g1.y);
      e[6] = lo2f(u.w) * __expf(rowc - b1.z + g1.z); e[7] = hi2f(u.w) * __expf(rowc - b1.w + g1.w);
#pragma unroll
      for (int q = 0; q < 8; q++) {
        int sq = s0 + q;
        bool ok = d ? (sq >= t) : (sq <= t);
        e[q] = ok ? 0.125f * e[q] : 0.f;
      }
      *(uint4*)(Sl + t * 136 + s0) = make_uint4(pack2(e[0], e[1]), pack2(e[2], e[3]), pack2(e[4], e[5]), pack2(e[6], e[7]));
    }
    __syncthreads();
    {
      int t = tid >> 1, hh = tid & 1;
      float rs = 0.f, qn = 0.f;
#pragma unroll
      for (int i = 0; i < 8; i++) {
        uint4 u = *(const uint4*)(Sl + t * 136 + hh * 64 + i * 8);
        rs += lo2f(u.x) + hi2f(u.x) + lo2f(u.y) + hi2f(u.y) + lo2f(u.z) + hi2f(u.z) + lo2f(u.w) + hi2f(u.w);
      }
      const bf* qp = Pb + pidx(rb + t, CQ + h * 64 + hh * 32);
      const float* np_ = nst + hh * 32;
#pragma unroll
      for (int i = 0; i < 4; i++) {
        uint4 u = *(const uint4*)(qp + i * 8);
        qn += lo2f(u.x) * np_[i * 8 + 0] + hi2f(u.x) * np_[i * 8 + 1] + lo2f(u.y) * np_[i * 8 + 2] + hi2f(u.y) * np_[i * 8 + 3] +
              lo2f(u.z) * np_[i * 8 + 4] + hi2f(u.z) * np_[i * 8 + 5] + lo2f(u.w) * np_[i * 8 + 6] + hi2f(u.w) * np_[i * 8 + 7];
      }
      rs += __shfl_xor(rs, 1);
      qn += __shfl_xor(qn, 1);
      if (hh == 0) {
        float den = rs + winter[t] * 0.125f * qn;
        dinv[t] = 1.f / fmaxf(fabsf(den), __expf(-mrow[t]));
      }
    }
    __syncthreads();
    {
      auto gA = [&](int kt, int r, int ko) -> uint4 {
        if (kt < 4) return scale8(*(const uint4*)(Sl + r * 136 + kt * 32 + ko), dinv[r]);
        uint4 q = *(const uint4*)(Pb + pidx(rb + r, CQ + h * 64 + (kt - 4) * 32 + ko));
        return scale8(q, winter[r] * 0.125f * dinv[r]);
      };
      auto gB = [&](int kt, int to, int c) -> uint4 {
        if (kt < 4) return *(const uint4*)(Pb + pidx(rb + kt * 32 + to, CV + h * 128 + c));
        return *(const uint4*)(slot + ((kt - 4) * 32 + to) * 128 + c);
      };
      block_gemm<128, 128, 32, false, true, true>(acch, gA, gB, 6, sA, sB, d == 0);
    }
    __syncthreads();
  }
  float* Hs = (float*)smem;
  acc_foreach<128, 128>(acch, [&](int t, int c, float v) { Hs[t * 132 + c] = v; });
  __syncthreads();
  {
    const int t = tid >> 1, hh = tid & 1;
    const float* hrow = Hs + t * 132 + hh * 64;
    float ss = 0.f;
#pragma unroll 4
    for (int i = 0; i < 16; i++) {
      float4 v = *(const float4*)(hrow + i * 4);
      ss += v.x * v.x + v.y * v.y + v.z * v.z + v.w * v.w;
    }
    ss += __shfl_xor(ss, 1);
    const float rstd = rsqrtf(ss * (1.f / 128.f) + EPS);
    const float* gh = p.g_hnorm + l * D + h * 128 + hh * 64;
#pragma unroll 2
    for (int i = 0; i < 8; i++) {
      bf* op = Pb + pidx(rb + t, CO + h * 128 + hh * 64 + i * 8);
      uint4 uo = *(const uint4*)op;
      uint4 uz = *(const uint4*)(Pb + pidx(rb + t, CZA + h * 128 + hh * 64 + i * 8));
      float4 h0 = *(const float4*)(hrow + i * 8), h1 = *(const float4*)(hrow + i * 8 + 4);
      float4 g0 = *(const float4*)(gh + i * 8), g1 = *(const float4*)(gh + i * 8 + 4);
      float y0 = h0.x * rstd * g0.x * sigm(lo2f(uo.x)) * silu(lo2f(uz.x));
      float y1 = h0.y * rstd * g0.y * sigm(hi2f(uo.x)) * silu(hi2f(uz.x));
      float y2 = h0.z * rstd * g0.z * sigm(lo2f(uo.y)) * silu(lo2f(uz.y));
      float y3 = h0.w * rstd * g0.w * sigm(hi2f(uo.y)) * silu(hi2f(uz.y));
      float y4 = h1.x * rstd * g1.x * sigm(lo2f(uo.z)) * silu(lo2f(uz.z));
      float y5 = h1.y * rstd * g1.y * sigm(hi2f(uo.z)) * silu(hi2f(uz.z));
      float y6 = h1.z * rstd * g1.z * sigm(lo2f(uo.w)) * silu(lo2f(uz.w));
      float y7 = h1.w * rstd * g1.w * sigm(hi2f(uo.w)) * silu(hi2f(uz.w));
      *(uint4*)op = make_uint4(pack2(y0, y1), pack2(y2, y3), pack2(y4, y5), pack2(y6, y7));
    }
  }
  __syncthreads();
}

DEV void phase6(const Params& p, int l, unsigned char* smem) {
  bf* sA = (bf*)smem;
  bf* sB = (bf*)(smem + OFF_SB);
  const int bid = obid();
  const int nxb = gridDim.x >> 3, xcd = bid & 7, lb = bid >> 3;
  if (l == 1) {
    bf* sA2 = (bf*)smem;
    bf* sB2 = (bf*)(smem + 40960);
    for (int t = xcd * 64 + lb; t < (xcd + 1) * 64; t += nxb) {
      int m256 = (t >> 6) * 8 + (t & 7), nt = (t >> 3) & 7;
      int rowbase = (m256 >> 5) * TB + 256 + (m256 & 31) * 256;
      const bf* A = p.P;
      const bf* B = p.wt_out + ((size_t)l * D + nt * 128) * 2048;
      f32x16 acc[4][2];
      auto gA = [&](int kt, int r, int ko) -> uint4 {
        int k = kt * 32;
        int col = (kt < 32 ? CO + k : (kt < 48 ? CU + (k - 1024) : CHR + (k - 1536))) + ko;
        return *(const uint4*)(A + pidx(rowbase + r, col));
      };
      auto gB = [&](int kt, int r, int ko) -> uint4 { return *(const uint4*)(B + (unsigned)(r * 2048 + kt * 32 + ko)); };
      block_gemm<256, 128, 32, false, false, true>(acc, gA, gB, 64, sA2, sB2);
      bf* Yt = p.ybuf + (size_t)rowbase * D + nt * 128;
      store_tile_bf16<256>(acc, (bf*)smem, [&](int row) -> bf* { return Yt + (unsigned)(row * D); }, 128);
    }
    return;
  }
  const int nmt = (l == 0) ? 132 : 128;
  const int per = nmt;
  for (int t = xcd * per + lb; t < (xcd + 1) * per; t += nxb) {
    int mtl, nt;
    if (t < 1024) { mtl = (t >> 6) * 8 + (t & 7); nt = (t >> 3) & 7; }
    else { mtl = 128 + ((t - 1024) & 3); nt = (t - 1024) >> 2; }
    int rowbase = (l == 0) ? mtl * 128 : ((mtl >> 6) * TB + 256 + (mtl & 63) * 128);
    const int mt = rowbase >> 7;
    const bf* A = p.P;
    const bf* B = p.wt_out + ((size_t)l * D + nt * 128) * 2048;
    f32x16 acc[2][2];
    auto gA = [&](int kt, int r, int ko) -> uint4 {
      int k = kt * 64;
      int col = (kt < 16 ? CO + k : (kt < 24 ? CU + (k - 1024) : CHR + (k - 1536))) + ko;
      return *(const uint4*)(A + pidx(rowbase + r, col));
    };
    auto gB = [&](int kt, int r, int ko) -> uint4 { return *(const uint4*)(B + (unsigned)(r * 2048 + kt * 64 + ko)); };
    block_gemm<128, 128, 64, false, false, true>(acc, gA, gB, 32, sA, sB);
    bf* Yt = p.ybuf + (size_t)mt * 128 * D + nt * 128;
    store_tile_bf16<128>(acc, (bf*)smem, [&](int row) -> bf* { return Yt + (unsigned)(row * D); }, 128);
  }
}

DEV void phase7(const Params& p, int l, int hf) {
  const int lane = otid() & 63, w = otid() >> 6;
  for (int rl = obid() * 4 + w; rl < HROWS; rl += gridDim.x * 4) {
    int r = hf * HROWS + rl;
    int b = r / TB, j = r % TB;
    const float* xin;
    float* xo;
    int mv;
    if (j < 256) {
      if (l != 0) continue;
      xin = p.ctx + ((size_t)b * 256 + j) * D;
      xo = p.xc1 + ((size_t)b * 256 + j) * D;
      mv = 4;
    } else {
      xin = (l == 0 ? p.x : p.out) + ((size_t)b * 8192 + (j - 256)) * D;
      xo = p.out + ((size_t)b * 8192 + (j - 256)) * D;
      mv = b;
    }
    const float* gt = p.mod + (size_t)(l * 5 + mv) * 3072 + 2048;
    const bf* yp = p.ybuf + (size_t)rl * D;
    float y[16];
    float ss = 0.f;
#pragma unroll
    for (int i = 0; i < 4; i++) {
      uint2 u = *(const uint2*)(yp + lane * 4 + 256 * i);
      y[i * 4 + 0] = lo2f(u.x); y[i * 4 + 1] = hi2f(u.x); y[i * 4 + 2] = lo2f(u.y); y[i * 4 + 3] = hi2f(u.y);
      ss += y[i * 4] * y[i * 4] + y[i * 4 + 1] * y[i * 4 + 1] + y[i * 4 + 2] * y[i * 4 + 2] + y[i * 4 + 3] * y[i * 4 + 3];
    }
#pragma unroll
    for (int off = 32; off; off >>= 1) ss += __shfl_xor(ss, off);
    float rstd = rsqrtf(ss * (1.f / 1024.f) + EPS);
#pragma unroll
    for (int i = 0; i < 4; i++) {
      int col = lane * 4 + 256 * i;
      float4 xv = nt_load4(xin + col);
      float4 g = *(const float4*)(p.g_post + l * D + col);
      float4 gv = *(const float4*)(gt + col);
      float4 o;
      o.x = xv.x + gv.x * (y[i * 4 + 0] * rstd * g.x);
      o.y = xv.y + gv.y * (y[i * 4 + 1] * rstd * g.y);
      o.z = xv.z + gv.z * (y[i * 4 + 2] * rstd * g.z);
      o.w = xv.w + gv.w * (y[i * 4 + 3] * rstd * g.w);
      nt_store4(xo + col, o);
    }
  }
}


#define XB_TMO      128
#define XB_XCNT(j)  (256  + 64 * (j))
#define XB_XSUB(j)  (1280 + 64 * (j))
#define XB_XGEN(j)  (2304 + 64 * (j))
#define XB_TOP      3328
#define XB_TOPGEN   3392
#define XCD_BAR_WORDS 3456
#define XB_SPIN_CAP (1u << 18)
#define LAS __attribute__((address_space(3)))
DEV unsigned xb_ld(unsigned* p) { return __hip_atomic_load(p, __ATOMIC_RELAXED, __HIP_MEMORY_SCOPE_AGENT); }
DEV unsigned xb_add(unsigned* p, unsigned v) { return __hip_atomic_fetch_add(p, v, __ATOMIC_RELAXED, __HIP_MEMORY_SCOPE_AGENT); }
DEV unsigned xb_xcc_id() { return (unsigned)__builtin_amdgcn_s_getreg((3 << 11) | 20) & 0xFu; }
#define XB_SPIN(cond, bar) do { unsigned _sp = 0; while (cond) { __builtin_amdgcn_s_sleep(1); \
    if ((++_sp & 255u) == 0u) { if (xb_ld(&(bar)[XB_TMO])) break; if (_sp > XB_SPIN_CAP) { atomicAdd(&(bar)[XB_TMO], 1u); break; } } } } while (0)
struct XcdBarrier {
  unsigned* bar;
  unsigned x;
  volatile LAS unsigned* st;
};
DEV XcdBarrier xcd_barrier_post(unsigned* bar, volatile LAS unsigned* st) {
  XcdBarrier b;
  b.bar = bar;
  b.x = xb_xcc_id();
  b.st = st;
  if (threadIdx.x == 0) (void)xb_add(&bar[XB_XCNT(b.x)], 1u);
  return b;
}
DEV void xcd_barrier_complete(unsigned* bar, unsigned x, unsigned& nloc, unsigned& nx) {
  const unsigned G = gridDim.x * gridDim.y * gridDim.z;
  unsigned sum, cnt, mine, sp = 0u;
  for (;;) {
    sum = 0u; cnt = 0u; mine = 0u;
#pragma unroll
    for (unsigned j = 0; j < 16; ++j) {
      const unsigned c = xb_ld(&bar[XB_XCNT(j)]);
      sum += c;
      cnt += (c > 0u) ? 1u : 0u;
      mine = (j == x) ? c : mine;
    }
    if (sum == G) break;
    __builtin_amdgcn_s_sleep(1);
    if ((++sp & 255u) == 0u) {
      if (xb_ld(&bar[XB_TMO])) break;
      if (sp > XB_SPIN_CAP) { atomicAdd(&bar[XB_TMO], 1u); break; }
    }
  }
  nloc = mine > 0u ? mine : 1u;
  nx = cnt > 0u ? cnt : 1u;
}
DEV void xcd_barrier(const XcdBarrier& b) {
  asm volatile("s_waitcnt vmcnt(0)" ::: "memory");
  __syncthreads();
  if (threadIdx.x == 0) {
    unsigned* bar = b.bar;
    __builtin_amdgcn_s_waitcnt(0);
    unsigned nloc = b.st[0], nx = b.st[1];
    if (nloc == 0u) {
      xcd_barrier_complete(bar, b.x, nloc, nx);
      b.st[0] = nloc;
      b.st[1] = nx;
    }
    const unsigned old = xb_add(&bar[XB_XSUB(b.x)], 1u);
    const unsigned gen = old / nloc;
    if (old + 1u == (gen + 1u) * nloc) {
      __builtin_amdgcn_fence(__ATOMIC_RELEASE, "agent");
      asm volatile("s_waitcnt vmcnt(0)" ::: "memory");
      const unsigned og = xb_add(&bar[XB_TOP], 1u);
      const unsigned tg = og / nx;
      if (og + 1u == (tg + 1u) * nx) xb_add(&bar[XB_TOPGEN], 1u);
      else XB_SPIN(xb_ld(&bar[XB_TOPGEN]) == tg, bar);
      __builtin_amdgcn_fence(__ATOMIC_ACQUIRE, "agent");
      xb_add(&bar[XB_XGEN(b.x)], 1u);
      asm volatile("s_waitcnt vmcnt(0)" ::: "memory");
    } else {
      XB_SPIN(xb_ld(&bar[XB_XGEN(b.x)]) == gen, bar);
      __builtin_amdgcn_fence(__ATOMIC_ACQUIRE, "agent");
      asm volatile("s_waitcnt vmcnt(0)" ::: "memory");
    }
  }
  __syncthreads();
}

__global__ void __launch_bounds__(256, 2) mk_forward(Params p) {
  extern __shared__ __attribute__((aligned(16))) unsigned char smem[];
  cg::grid_group grid = cg::this_grid();
  volatile LAS unsigned* xst = (volatile LAS unsigned*)(smem + LDS_BYTES - 16);
  if (threadIdx.x == 0) { xst[0] = 0u; xst[1] = 0u; xst[2] = 0u; xst[3] = 0u; }
  __syncthreads();
  XcdBarrier xb = xcd_barrier_post(p.bar, xst);
  phase0a(p, smem);
  if (p.bar == nullptr) grid.sync();
  xcd_barrier(xb);
  phase0b(p, smem);
  phase1(p, 0);
  xcd_barrier(xb);
  for (int l = 0; l < 2; l++) {
    for (int hf = 0; hf < 2; hf++) {
      if (hf == 0) {
        phase2(p, l, 0, smem);
        xcd_barrier(xb);
      }
      phase3(p, l, smem);
      xcd_barrier(xb);
      phase4(p, l, smem);
      xcd_barrier(xb);
      for (int it = obid(); it < (l == 0 ? 1056 : 1024); it += gridDim.x) mlstm_out_item(p, l, it, smem);
      xcd_barrier(xb);
      phase6(p, l, smem);
      xcd_barrier(xb);
      phase7(p, l, hf);
      if (hf == 0) {
        phase2(p, l, 1, smem);
        xcd_barrier(xb);
      }
    }
    if (l == 0) {
      xcd_barrier(xb);
      phase1(p, 1);
      xcd_barrier(xb);
    }
  }
}

extern "C" void kernel_launch(void* const* d_in, const int* in_sizes, int n_in, void* d_out, int out_size, void* d_ws,
                              size_t ws_size, hipStream_t stream) {
  static int grid_blocks = 0;
  if (grid_blocks == 0) {
    int dev = 0, cus = 0, per_cu = 0;
    hipGetDevice(&dev);
    hipDeviceGetAttribute(&cus, hipDeviceAttributeMultiprocessorCount, dev);
    if (hipFuncSetAttribute((const void*)mk_forward, hipFuncAttributeMaxDynamicSharedMemorySize, LDS_BYTES) != hipSuccess) {
      fprintf(stderr, "hipFuncSetAttribute failed\n");
    }
    if (hipOccupancyMaxActiveBlocksPerMultiprocessor(&per_cu, (const void*)mk_forward, 256, LDS_BYTES) != hipSuccess || per_cu < 1) {
      fprintf(stderr, "occupancy query failed (%d)\n", per_cu);
      per_cu = 1;
    }
    (void)hipGetLastError();
    if (per_cu > 2) per_cu = 2;
    grid_blocks = cus * per_cu;
  }
  Params p{};
  p.x = (const float*)d_in[0]; p.c = (const float*)d_in[1]; p.ctx = (const float*)d_in[2]; p.c_ctx = (const float*)d_in[3];
  p.w_mod = (const float*)d_in[4]; p.b_mod = (const float*)d_in[5]; p.g_pre = (const float*)d_in[6];
  p.g_post = (const float*)d_in[7]; p.w_in = (const float*)d_in[8]; p.b_gate = (const float*)d_in[9];
  p.g_hnorm = (const float*)d_in[10]; p.g_sgu = (const float*)d_in[11]; p.w_sp = (const float*)d_in[12];
  p.b_sp = (const float*)d_in[13]; p.w_fno = (const float*)d_in[14]; p.b_fno = (const float*)d_in[15];
  p.w_out = (const float*)d_in[16];
  p.out = (float*)d_out;
  size_t off = 0;
  unsigned char* ws = (unsigned char*)d_ws;
  auto take = [&](size_t bytes) -> void* {
    void* r = ws + off;
    off += (bytes + 255) & ~(size_t)255;
    return r;
  };
  p.wt_in = (bf*)take((size_t)2 * NPW * D * 2);
  p.wt_out = (bf*)take((size_t)2 * D * 2048 * 2);
  p.wsp = (bf*)take((size_t)2 * 4 * 128 * 128 * 2);
  p.m1 = (bf*)take(128 * 128 * 2);
  p.m2 = (bf*)take(128 * 256 * 2);
  p.mctx = (bf*)take(256 * 512 * 2);
  p.hN = (bf*)take((size_t)ROWS * D * 2);
  p.P = (bf*)take((size_t)57 * HROWS * 128 * 2);
  p.abuf = (bf*)take((size_t)2 * 64 * 2 * 128 * 512 * 2);
  p.ybuf = (bf*)take((size_t)HROWS * D * 2);
  p.cbuf = (bf*)take((size_t)2 * 256 * 512 * 2);
  p.mod = (float*)take(2 * 5 * 3072 * 4);
  p.tw = (float*)take(128 * 64 * 8);
  p.Q = (float*)take((size_t)2 * 4 * 128 * 256 * 4);
  p.gates = (float*)take((size_t)HROWS * 32 * 4);
  p.states = (bf*)take((size_t)32 * 66 * 8192 * 2);
  p.nbuf = (float*)take((size_t)32 * 66 * 64 * 4);
  p.scal = (float*)take(32 * 66 * 2 * 4);
  p.mstart = (float*)take(32 * 66 * 4);
  p.xc1 = (float*)take((size_t)1024 * 1024 * 4);
  p.bar = (unsigned*)take((size_t)XCD_BAR_WORDS * 4);
  if (off > ws_size) {
    fprintf(stderr, "workspace too small: need %zu have %zu\n", off, ws_size);
    return;
  }
  if (hipMemsetAsync(p.bar, 0, (size_t)XCD_BAR_WORDS * 4, stream) != hipSuccess) fprintf(stderr, "memset failed\n");
  void* args[] = {&p};
  hipError_t e = hipLaunchCooperativeKernel((const void*)mk_forward, dim3(grid_blocks), dim3(256), args, LDS_BYTES, stream);
  if (e != hipSuccess) fprintf(stderr, "cooperative launch failed: %s (grid %d)\n", hipGetErrorString(e), grid_blocks);
}
```

```cpp
#include <hip/hip_runtime.h>
#include <hip/hip_cooperative_groups.h>
#include <cstdio>
namespace cg = cooperative_groups;

typedef unsigned short bf;
typedef __attribute__((ext_vector_type(8))) short bf16x8;
typedef __attribute__((ext_vector_type(16))) float f32x16;

#define DEV __device__ __forceinline__

constexpr int D = 1024, TB = 8448, ROWS = 33792, HROWS = 16896;
constexpr int NP = 7200, NPW = 7296, NIN = 6688;
constexpr int CQ = 0, CK = 512, CV = 1024, CO = 2048, CZA = 3072, CU = 4096, CVS = 4608, CZB = 5120,
              CHR = 5632, CZC = 6144, CHI = 6656, CG = 7168;
constexpr int SRC_G = 2048, SRC_F = 5664;
constexpr int SSLOT = 8256;
constexpr float EPS = 1e-6f;
constexpr int BKP = 40;
constexpr int LDS_BYTES = 80896;
constexpr int OFF_SB = 36864, OFF_SB32 = 20480, OFF_SL = 40960, OFF_VEC = 75776;

struct Params {
  const float *x, *c, *ctx, *c_ctx, *w_mod, *b_mod, *g_pre, *g_post, *w_in, *b_gate, *g_hnorm, *g_sgu, *w_sp, *b_sp,
      *w_fno, *b_fno, *w_out;
  float* out;
  bf *wt_in, *wt_out, *wsp, *m1, *m2, *mctx, *hN, *P, *abuf, *ybuf, *cbuf, *states;
  float *mod, *tw, *Q, *gates, *nbuf, *scal, *mstart, *xc1;
  unsigned* bar;
};

typedef __attribute__((ext_vector_type(2))) __bf16 bf16x2_t;
typedef __attribute__((ext_vector_type(2))) float f32x2_t;
DEV unsigned pack2(float a, float b) {
  f32x2_t f = {a, b};
  bf16x2_t h = __builtin_convertvector(f, bf16x2_t);
  return __builtin_bit_cast(unsigned, h);
}
DEV bf f2bf(float f) { return (bf)(pack2(f, f) & 0xffffu); }
DEV float bf2f(bf h) { return __uint_as_float(((unsigned)h) << 16); }
DEV float lo2f(unsigned u) { return __uint_as_float(u << 16); }
DEV float hi2f(unsigned u) { return __uint_as_float(u & 0xffff0000u); }
DEV int otid() {
  int t = threadIdx.x;
  asm volatile("" : "+v"(t));
  return t;
}
DEV int obid() {
  int b = blockIdx.x;
  asm volatile("" : "+s"(b));
  return b;
}
DEV unsigned pidx(int row, int col) { return (unsigned)(((col >> 7) * HROWS + row) * 128 + (col & 127)); }
typedef __attribute__((ext_vector_type(4))) float f32x4v;
DEV float4 nt_load4(const float* p) {
  f32x4v v = __builtin_nontemporal_load((const f32x4v*)p);
  return make_float4(v[0], v[1], v[2], v[3]);
}
DEV void nt_store4(float* p, float4 o) {
  f32x4v v = {o.x, o.y, o.z, o.w};
  __builtin_nontemporal_store(v, (f32x4v*)p);
}
DEV float silu(float x) { return x / (1.f + __expf(-x)); }
DEV float sigm(float x) { return 1.f / (1.f + __expf(-x)); }
DEV float logsigmoid(float x) { return fminf(x, 0.f) - log1pf(__expf(-fabsf(x))); }

typedef __attribute__((ext_vector_type(4))) unsigned u32x4;
typedef __attribute__((ext_vector_type(4))) short s16x4;
DEV bf16x8 tr_frag(const bf* p, int ld) {
  typedef __attribute__((address_space(3))) s16x4 lds_s16x4;
  s16x4 t0 = __builtin_amdgcn_ds_read_tr16_b64_v4i16((lds_s16x4*)p);
  s16x4 t1 = __builtin_amdgcn_ds_read_tr16_b64_v4i16((lds_s16x4*)(p + 4 * ld));
  bf16x8 f = {t0[0], t0[1], t0[2], t0[3], t1[0], t1[1], t1[2], t1[3]};
  return f;
}
template <int BM, int BN, int BK, bool ATOK, bool BTOK, bool PF2 = false, class FA, class FB>
DEV void block_gemm(f32x16 (&acc)[BM / 64][BN / 64], FA getA, FB getB, int nkt, bf* sA, bf* sB, bool zero = true) {
  constexpr int MT = BM / 64, NTl = BN / 64, KV = BK / 8, NA = BM * KV / 256, NB = BN * KV / 256;
  constexpr int LDK = BK + 8;
  constexpr int LDAT = BM + 8, LDBT = BN + 8;
  constexpr int XBUFA = ATOK ? BK * LDAT : BM * LDK, XBUFB = BTOK ? BK * LDBT : BN * LDK;
  const int tid = otid(), lane = tid & 63, w = tid >> 6, wm = w >> 1, wn = w & 1;
  uint4 ra[NA], rb[NB];
  if (zero) {
#pragma unroll
    for (int i = 0; i < MT; i++)
#pragma unroll
      for (int j = 0; j < NTl; j++)
#pragma unroll
        for (int r = 0; r < 16; r++) acc[i][j][r] = 0.f;
  }

#define BG_FETCH(kt, RA, RB)                                                          \
  {                                                                                   \
    _Pragma("unroll") for (int i = 0; i < NA; i++) {                                  \
      int idx = tid + 256 * i;                                                        \
      if (ATOK) RA[i] = getA((kt), idx / (BM / 8), (idx % (BM / 8)) * 8);              \
      else RA[i] = getA((kt), idx / KV, (idx % KV) * 8);                              \
    }                                                                                 \
    _Pragma("unroll") for (int i = 0; i < NB; i++) {                                  \
      int idx = tid + 256 * i;                                                        \
      if (BTOK) RB[i] = getB((kt), idx / (BN / 8), (idx % (BN / 8)) * 8);              \
      else RB[i] = getB((kt), idx / KV, (idx % KV) * 8);                              \
    }                                                                                 \
  }
#define BG_STASH(buf, RA, RB)                                                         \
  {                                                                                   \
    _Pragma("unroll") for (int i = 0; i < NA; i++) {                                  \
      int idx = tid + 256 * i;                                                        \
      if (ATOK) *(uint4*)(sA + (buf) * XBUFA + (idx / (BM / 8)) * LDAT + (idx % (BM / 8)) * 8) = RA[i]; \
      else *(uint4*)(sA + (buf) * XBUFA + (idx / KV) * LDK + (idx % KV) * 8) = RA[i];  \
    }                                                                                 \
    _Pragma("unroll") for (int i = 0; i < NB; i++) {                                  \
      int idx = tid + 256 * i;                                                        \
      if (BTOK) *(uint4*)(sB + (buf) * XBUFB + (idx / (BN / 8)) * LDBT + (idx % (BN / 8)) * 8) = RB[i]; \
      else *(uint4*)(sB + (buf) * XBUFB + (idx / KV) * LDK + (idx % KV) * 8) = RB[i];  \
    }                                                                                 \
  }
#define BG_COMPUTE(buf)                                                               \
  _Pragma("unroll") for (int ks = 0; ks < BK / 16; ks++) {                            \
    bf16x8 a[MT], b[NTl];                                                             \
    _Pragma("unroll") for (int i = 0; i < MT; i++) {                                  \
      if (ATOK) {                                                                     \
        a[i] = tr_frag(sA + (buf) * XBUFA + (ks * 16 + (lane >> 5) * 8 + ((lane & 15) >> 2)) * LDAT + wm * (BM / 2) + i * 32 + \
                       ((lane >> 4) & 1) * 16 + (lane & 3) * 4, LDAT);                \
      } else {                                                                        \
        a[i] = *(const bf16x8*)(sA + (buf) * XBUFA + (wm * (BM / 2) + i * 32 + (lane & 31)) * LDK + ks * 16 + (lane >> 5) * 8); \
      }                                                                               \
    }                                                                                 \
    _Pragma("unroll") for (int j = 0; j < NTl; j++) {                                 \
      if (BTOK) {                                                                     \
        b[j] = tr_frag(sB + (buf) * XBUFB + (ks * 16 + (lane >> 5) * 8 + ((lane & 15) >> 2)) * LDBT + wn * (BN / 2) + j * 32 + \
                       ((lane >> 4) & 1) * 16 + (lane & 3) * 4, LDBT);                \
      } else {                                                                        \
        b[j] = *(const bf16x8*)(sB + (buf) * XBUFB + (wn * (BN / 2) + j * 32 + (lane & 31)) * LDK + ks * 16 + (lane >> 5) * 8); \
      }                                                                               \
    }                                                                                 \
    _Pragma("unroll") for (int i = 0; i < MT; i++)                                    \
      _Pragma("unroll") for (int j = 0; j < NTl; j++)                                 \
        acc[i][j] = __builtin_amdgcn_mfma_f32_32x32x16_bf16(a[i], b[j], acc[i][j], 0, 0, 0); \
    if (!ATOK && !BTOK) __builtin_amdgcn_iglp_opt(0);                                 \
  }

  if (PF2) {
    uint4 ra2[NA], rb2[NB];
    BG_FETCH(0, ra, rb);
    BG_FETCH(1, ra2, rb2);
    BG_STASH(0, ra, rb);
    __syncthreads();
#pragma unroll 1
    for (int kt = 0; kt < nkt; kt += 2) {
      const int k2 = min(kt + 2, nkt - 1), k3 = min(kt + 3, nkt - 1);
      BG_FETCH(k2, ra, rb);
      BG_COMPUTE(0);
      BG_STASH(1, ra2, rb2);
      __syncthreads();
      BG_FETCH(k3, ra2, rb2);
      BG_COMPUTE(1);
      BG_STASH(0, ra, rb);
      __syncthreads();
    }
  } else {
    BG_FETCH(0, ra, rb);
    BG_STASH(0, ra, rb);
    __syncthreads();
#pragma unroll 1
    for (int kt = 0; kt < nkt; kt++) {
      const int buf = kt & 1;
      if (kt + 1 < nkt) BG_FETCH(kt + 1, ra, rb);
      BG_COMPUTE(buf);
      if (kt + 1 < nkt) BG_STASH(buf ^ 1, ra, rb);
      __syncthreads();
    }
  }
#undef BG_FETCH
#undef BG_STASH
#undef BG_COMPUTE
}

template <int BM, class FD>
DEV void store_tile_bf16(f32x16 (&acc)[BM / 64][2], bf* Cs, FD dst, int ncols_valid) {
  acc_foreach<BM, 128>(acc, [&](int row, int col, float v) { Cs[row * 136 + col] = f2bf(v); });
  __syncthreads();
  const int tid = otid();
#pragma unroll 4
  for (int i = 0; i < BM / 16; i++) {
    int idx = tid + 256 * i;
    int row = idx >> 4, c8 = (idx & 15) * 8;
    uint4 v = *(const uint4*)(Cs + row * 136 + c8);
    if (c8 < ncols_valid) *(uint4*)(dst(row) + c8) = v;
  }
  __syncthreads();
}

DEV uint4 scale8(uint4 q, float sc) {
  return make_uint4(pack2(lo2f(q.x) * sc, hi2f(q.x) * sc), pack2(lo2f(q.y) * sc, hi2f(q.y) * sc),
                    pack2(lo2f(q.z) * sc, hi2f(q.z) * sc), pack2(lo2f(q.w) * sc, hi2f(q.w) * sc));
}

template <int BM, int BN, class F>
DEV void acc_foreach(f32x16 (&acc)[BM / 64][BN / 64], F f) {
  const int tid_ = otid();
  const int lane = tid_ & 63, w = tid_ >> 6, wm = w >> 1, wn = w & 1;
#pragma unroll
  for (int i = 0; i < BM / 64; i++)
#pragma unroll
    for (int j = 0; j < BN / 64; j++)
#pragma unroll
      for (int r = 0; r < 16; r++) {
        int row = wm * (BM / 2) + i * 32 + (r & 3) + 8 * (r >> 2) + 4 * (lane >> 5);
        int col = wn * (BN / 2) + j * 32 + (lane & 31);
        f(row, col, acc[i][j][r]);
        if (r == 15) asm volatile("" ::: "memory");
      }
}

DEV void conv_tile(const float* __restrict__ src, int srcld, int sn0, int nvalid, bf* __restrict__ dst, int dstld, int n0, int k0,
                   float* tile) {
  const int tid = otid();
  {
    float4 v[4];
#pragma unroll
    for (int i = 0; i < 4; i++) {
      int idx = tid + 256 * i;
      int kk = idx >> 4, n4 = (idx & 15) * 4;
      v[i] = make_float4(0.f, 0.f, 0.f, 0.f);
      if (n4 < nvalid) v[i] = *(const float4*)(src + (size_t)(k0 + kk) * srcld + sn0 + n4);
    }
#pragma unroll
    for (int i = 0; i < 4; i++) {
      int idx = tid + 256 * i;
      int kk = idx >> 4, n4 = (idx & 15) * 4;
      tile[kk * 65 + n4] = v[i].x; tile[kk * 65 + n4 + 1] = v[i].y; tile[kk * 65 + n4 + 2] = v[i].z; tile[kk * 65 + n4 + 3] = v[i].w;
    }
  }
  __syncthreads();
#pragma unroll 4
  for (int i = 0; i < 16; i++) {
    int idx = tid + 256 * i;
    int nn = idx >> 6, kk = idx & 63;
    int n = n0 + nn;
    dst[(size_t)n * dstld + k0 + kk] = f2bf(tile[kk * 65 + nn]);
  }
  __syncthreads();
}

DEV void phase0a(const Params& p, unsigned char* smem) {
  const int tid = otid();
  float* fs = (float*)smem;
  for (int it = obid(); it < 2 * 114 * 16; it += gridDim.x) {
    int kt = it & 15, nt = (it >> 4) % 114, l = it / (114 * 16);
    const int n0 = nt * 64;
    int sn0 = n0, nvalid = 64;
    if (n0 < 2048) sn0 = n0;
    else if (n0 < CHR) sn0 = n0 + 32;
    else if (n0 < CZC) continue;
    else if (n0 < CHI) sn0 = n0 + 32;
    else if (n0 < CG) continue;
    else if (n0 == CG) { sn0 = SRC_G; nvalid = 32; }
    else { sn0 = 0; nvalid = 0; }
    conv_tile(p.w_in + (size_t)l * D * NIN, NIN, sn0, nvalid, p.wt_in + (size_t)l * NPW * D, D, n0, kt * 64, fs);
  }
  for (int it = obid(); it < 2 * 16 * 32; it += gridDim.x) {
    int kt = it & 31, nt = (it >> 5) & 15, l = it >> 9;
    conv_tile(p.w_out + (size_t)l * 2048 * D, D, nt * 64, 64, p.wt_out + (size_t)l * D * 2048, 2048, nt * 64, kt * 64, fs);
  }
  for (int it = obid(); it < 96; it += gridDim.x) {
    int l = it / 48, j0 = (it % 48) * 64;
    float* sc = fs;
    float* red = fs + 5 * 1024;
    for (int i = tid; i < 5 * 1024; i += 256) {
      int v = i >> 10, k = i & 1023;
      float cv = (v < 4) ? p.c[v * D + k] : p.c_ctx[k];
      sc[i] = silu(cv);
    }
    __syncthreads();
    int col = tid & 63, ks = tid >> 6;
    float a0 = 0, a1 = 0, a2 = 0, a3 = 0, a4 = 0;
    const float* wp = p.w_mod + (size_t)l * D * 3072 + j0 + col;
#pragma unroll 16
    for (int k = ks * 256; k < ks * 256 + 256; k++) {
      float wv = wp[(size_t)k * 3072];
      a0 += sc[k] * wv; a1 += sc[1024 + k] * wv; a2 += sc[2048 + k] * wv; a3 += sc[3072 + k] * wv; a4 += sc[4096 + k] * wv;
    }
    red[(ks * 5 + 0) * 64 + col] = a0; red[(ks * 5 + 1) * 64 + col] = a1; red[(ks * 5 + 2) * 64 + col] = a2;
    red[(ks * 5 + 3) * 64 + col] = a3; red[(ks * 5 + 4) * 64 + col] = a4;
    __syncthreads();
    for (int i = tid; i < 5 * 64; i += 256) {
      int v = i >> 6, cc = i & 63;
      float s = red[(0 * 5 + v) * 64 + cc] + red[(1 * 5 + v) * 64 + cc] + red[(2 * 5 + v) * 64 + cc] + red[(3 * 5 + v) * 64 + cc];
      p.mod[(l * 5 + v) * 3072 + j0 + cc] = s + p.b_mod[l * 3072 + j0 + cc];
    }
    __syncthreads();
  }
  const int gtid = obid() * 256 + tid, gsz = gridDim.x * 256;
  for (int i = gtid; i < 2 * 4 * 128 * 128; i += gsz) p.wsp[i] = f2bf(p.w_sp[i]);
  for (int i = gtid; i < 128 * 128; i += gsz) {
    int m = i >> 7, k = i & 127;
    int wmm = m >> 6, rip = (m >> 5) & 1, k1 = wmm * 32 + (m & 31);
    int ri = k >> 6, t1 = k & 63;
    float s, c;
    sincospif((float)((k1 * t1) & 63) / 32.f, &s, &c);
    float v = rip == 0 ? (ri == 0 ? c : s) : (ri == 0 ? -s : c);
    p.m1[i] = f2bf(v);
  }
  for (int i = gtid; i < 128 * 256; i += gsz) {
    int k2 = i >> 8, k = i & 255;
    int ri = k >> 7, t2 = k & 127;
    float s, c;
    sincospif((float)((t2 * k2) & 127) / 64.f, &s, &c);
    p.m2[i] = f2bf(ri == 0 ? c : s);
  }
  for (int i = gtid; i < 256 * 512; i += gsz) {
    int tp = i >> 9, k = i & 511;
    int ri = k >> 8, t = k & 255;
    float s, c;
    sincospif((float)((t * tp) & 255) / 128.f, &s, &c);
    p.mctx[i] = f2bf(ri == 0 ? c : s);
  }
  for (int i = gtid; i < 128 * 64; i += gsz) {
    int t2 = i >> 6, k1 = i & 63;
    float s, c;
    sincospif((float)(t2 * k1) / 4096.f, &s, &c);
    p.tw[2 * i] = c;
    p.tw[2 * i + 1] = s;
  }
  __syncthreads();
  if (tid < 128) {
    float s, co;
    sincospif((float)tid / 64.f, &s, &co);
    fs[tid] = co;
    fs[128 + tid] = -s;
  }
  __syncthreads();
  for (int i = gtid; i < 2 * 4 * 128 * 256; i += gsz) {
    int d = i & 127, ri = (i >> 7) & 1, c = (i >> 8) & 127, lg = i >> 15;
    const float* wf = p.w_fno + (size_t)lg * 128 * 128 + d;
    const float* tr = fs + ri * 128;
    float acc = 0.f;
#pragma unroll 8
    for (int cp = 0; cp < 128; cp++) acc += tr[(c * cp) & 127] * wf[cp * 128];
    p.Q[i] = acc * 0.08838834764831845f;
  }
}

DEV void phase0b(const Params& p, unsigned char* smem) {
  const int tid = otid();
  float* wl = (float*)smem;
  for (int it = obid(); it < 256; it += gridDim.x) {
    int l = it >> 7, k0 = (it & 127) * 8;
    const float* wsrc = p.w_in + (size_t)l * D * NIN + (size_t)k0 * NIN + SRC_F;
    {
      float4 wv4[4];
#pragma unroll
      for (int i = 0; i < 4; i++) {
        int idx = tid + 256 * i;
        int kk = idx >> 7, f4 = (idx & 127) * 4;
        wv4[i] = *(const float4*)(wsrc + (size_t)kk * NIN + f4);
      }
#pragma unroll
      for (int i = 0; i < 4; i++) {
        int idx = tid + 256 * i;
        int kk = idx >> 7, f4 = (idx & 127) * 4;
        wl[(f4 + 0) * 8 + kk] = wv4[i].x; wl[(f4 + 1) * 8 + kk] = wv4[i].y; wl[(f4 + 2) * 8 + kk] = wv4[i].z; wl[(f4 + 3) * 8 + kk] = wv4[i].w;
      }
    }
    __syncthreads();
    for (int jj = 0; jj < 4; jj++) {
      int np = tid + 256 * jj;
      int d = np & 127, g = (np >> 7) & 3, ri = np >> 9;
      float acc[8];
#pragma unroll
      for (int kk = 0; kk < 8; kk++) acc[kk] = 0.f;
      const float* qp = p.Q + ((size_t)(l * 4 + g) * 128) * 256 + ri * 128 + d;
      const float* wp = wl + g * 128 * 8;
#pragma unroll 16
      for (int c = 0; c < 128; c++) {
        float qv = qp[c * 256];
        float4 w0 = *(const float4*)(wp + c * 8), w1 = *(const float4*)(wp + c * 8 + 4);
        acc[0] += w0.x * qv; acc[1] += w0.y * qv; acc[2] += w0.z * qv; acc[3] += w0.w * qv;
        acc[4] += w1.x * qv; acc[5] += w1.y * qv; acc[6] += w1.z * qv; acc[7] += w1.w * qv;
      }
      int n = (ri ? CHI : CHR) + g * 128 + d;
      uint4 o = make_uint4(pack2(acc[0], acc[1]), pack2(acc[2], acc[3]), pack2(acc[4], acc[5]), pack2(acc[6], acc[7]));
      *(uint4*)(p.wt_in + ((size_t)l * NPW + n) * D + k0) = o;
    }
    __syncthreads();
  }
}

DEV void phase1(const Params& p, int l) {
  const int lane = otid() & 63, w = otid() >> 6;
  for (int r = obid() * 4 + w; r < ROWS; r += gridDim.x * 4) {
    int b = r / TB, j = r % TB;
    const float* xin;
    int mv;
    if (j < 256) {
      xin = (l == 0 ? p.ctx : p.xc1) + ((size_t)b * 256 + j) * D;
      mv = 4;
    } else {
      xin = (l == 0 ? p.x : p.out) + ((size_t)b * 8192 + (j - 256)) * D;
      mv = b;
    }
    const float* md = p.mod + (size_t)(l * 5 + mv) * 3072;
    float4 v[4];
    float ss = 0.f;
#pragma unroll
    for (int i = 0; i < 4; i++) {
      v[i] = nt_load4(xin + lane * 4 + 256 * i);
      ss += v[i].x * v[i].x + v[i].y * v[i].y + v[i].z * v[i].z + v[i].w * v[i].w;
    }
#pragma unroll
    for (int off = 32; off; off >>= 1) ss += __shfl_xor(ss, off);
    float rstd = rsqrtf(ss * (1.f / 1024.f) + EPS);
#pragma unroll
    for (int i = 0; i < 4; i++) {
      int col = lane * 4 + 256 * i;
      float4 g = *(const float4*)(p.g_pre + l * D + col);
      float4 sh = *(const float4*)(md + col);
      float4 sc = *(const float4*)(md + 1024 + col);
      float o0 = v[i].x * rstd * g.x * (1.f + sc.x) + sh.x;
      float o1 = v[i].y * rstd * g.y * (1.f + sc.y) + sh.y;
      float o2 = v[i].z * rstd * g.z * (1.f + sc.z) + sh.z;
      float o3 = v[i].w * rstd * g.w * (1.f + sc.w) + sh.w;
      *(uint2*)(p.hN + (size_t)r * D + col) = make_uint2(pack2(o0, o1), pack2(o2, o3));
    }
  }
}

DEV void phase2(const Params& p, int l, int hf, unsigned char* smem) {
  bf* sA = (bf*)smem;
  bf* sB = (bf*)(smem + 40960);
  const int bid = obid();
  const int nxb = gridDim.x >> 3, xcd = bid & 7, lb = bid >> 3;
  const int per = (66 * 57 + 7) / 8;
  const int tend = min((xcd + 1) * per, 66 * 57);
  for (int t = xcd * per + lb; t < tend; t += nxb) {
    int ms, rem, rows_in;
    if (t < 8 * 8 * 57) { ms = t / 456; rem = t - ms * 456; rows_in = 8; }
    else { ms = 8; rem = t - 8 * 456; rows_in = 2; }
    int ns = rem / (rows_in * 8);
    if (ns > 7) ns = 7;
    int r2 = rem - ns * rows_in * 8;
    int mt = ms * 8 + (r2 % rows_in), nt = ns * 8 + (r2 / rows_in);
    const bf* A = p.hN + ((size_t)hf * HROWS + mt * 256) * D;
    const bf* B = p.wt_in + ((size_t)l * NPW + nt * 128) * D;
    f32x16 acc[4][2];
    auto gA = [&](int kt, int r, int ko) -> uint4 { return *(const uint4*)(A + (unsigned)(r * D + kt * 32 + ko)); };
    auto gB = [&](int kt, int r, int ko) -> uint4 { return *(const uint4*)(B + (unsigned)(r * D + kt * 32 + ko)); };
    block_gemm<256, 128, 32, false, false, true>(acc, gA, gB, 32, sA, sB);
    if (nt == CG / 128) {
      acc_foreach<256, 128>(acc, [&](int row, int col, float v) {
        if (col < 32) p.gates[(unsigned)((mt * 256 + row) * 32 + col)] = v + p.b_gate[l * 32 + col];
      });
    }
    store_tile_bf16<256>(acc, (bf*)smem, [&](int row) -> bf* { return p.P + pidx(mt * 256 + row, nt * 128); }, min(128, NP - nt * 128));
  }
}

DEV void gate_prep(const float* __restrict__ gch, int h, float* vec, bool want_w) {
  const int tid = otid(), lane = tid & 63, w = tid >> 6;
  if (w < 2) {
    const int d = w;
    int p0 = 2 * lane, p1 = p0 + 1;
    int i0 = d ? 127 - p0 : p0, i1 = d ? 127 - p1 : p1;
    float ig0 = gch[i0 * 32 + (2 * d) * 8 + h], ig1 = gch[i1 * 32 + (2 * d) * 8 + h];
    float lf0 = logsigmoid(gch[i0 * 32 + (2 * d + 1) * 8 + h]), lf1 = logsigmoid(gch[i1 * 32 + (2 * d + 1) * 8 + h]);
    float incl = lf0 + lf1;
#pragma unroll
    for (int off = 1; off < 64; off <<= 1) {
      float t = __shfl_up(incl, off);
      if (lane >= off) incl += t;
    }
    float b1 = incl, b0 = incl - lf1;
    float a0 = ig0 - b0, a1 = ig1 - b1;
    float mincl = fmaxf(a0, a1);
#pragma unroll
    for (int off = 1; off < 64; off <<= 1) {
      float t = __shfl_up(mincl, off);
      if (lane >= off) mincl = fmaxf(mincl, t);
    }
    float prev = __shfl_up(mincl, 1);
    float pm0 = lane ? fmaxf(prev, a0) : a0, pm1 = mincl;
    float tot = __shfl(b1, 63);
    vec[d * 128 + i0] = ig0;
    vec[d * 128 + i1] = ig1;
    vec[256 + d * 128 + i0] = b0;
    vec[256 + d * 128 + i1] = b1;
    if (want_w) {
      float wl0 = tot - b0 + ig0, wl1 = tot - b1 + ig1;
      float mx = fmaxf(wl0, wl1);
#pragma unroll
      for (int off = 32; off; off >>= 1) mx = fmaxf(mx, __shfl_xor(mx, off));
      vec[512 + d * 128 + i0] = __expf(wl0 - mx);
      vec[512 + d * 128 + i1] = __expf(wl1 - mx);
      if (lane == 0) {
        vec[1152 + d * 2] = tot;
        vec[1152 + d * 2 + 1] = mx;
      }
    } else {
      vec[512 + d * 128 + i0] = pm0;
      vec[512 + d * 128 + i1] = pm1;
      if (lane == 0) vec[1152 + d * 2] = tot;
    }
  }
  __syncthreads();
}

DEV void mlstm_dc_item(const Params& p, int it, unsigned char* smem) {
  bf* sA = (bf*)smem;
  bf* sB = (bf*)(smem + OFF_SB);
  float* vec = (float*)(smem + OFF_VEC);
  const int tid = otid();
  int j = it % 66, h = (it / 66) & 7, bl = it / 528;
  size_t base = (size_t)bl * TB + j * 128;
  gate_prep(p.gates + base * 32, h, vec, true);
  const bf* Pb = p.P;
  const int rb = (int)base;
  for (int d = 0; d < 2; d++) {
    int sid = (bl * 8 + h) * 2 + d;
    bf* slot = p.states + ((size_t)sid * 66 + j) * 8192;
    float* nslot = p.nbuf + ((size_t)sid * 66 + j) * 64;
    const float* wv = vec + 512 + d * 128;
    f32x16 acc[1][2];
    auto gA = [&](int kt, int to, int c) -> uint4 {
      int tok = kt * 64 + to;
      return *(const uint4*)(Pb + pidx(rb + tok, CK + h * 64 + c));
    };
    auto gB = [&](int kt, int to, int c) -> uint4 {
      int tok = kt * 64 + to;
      return scale8(*(const uint4*)(Pb + pidx(rb + tok, CV + h * 128 + c)), wv[tok]);
    };
    block_gemm<64, 128, 64, true, true, true>(acc, gA, gB, 2, sA, sB);
    store_tile_bf16<64>(acc, (bf*)smem, [&](int row) -> bf* { return slot + row * 128; }, 128);
    {
      float* red = vec + 768;
      int dk = tid & 63, part = tid >> 6;
      float sacc = 0.f;
#pragma unroll 8
      for (int t = part * 32; t < part * 32 + 32; t++) sacc += wv[t] * bf2f(Pb[pidx(rb + t, CK + h * 64 + dk)]);
      red[part * 64 + dk] = sacc;
      __syncthreads();
      if (tid < 64) nslot[tid] = red[tid] + red[64 + tid] + red[128 + tid] + red[192 + tid];
    }
    if (tid == 0) {
      p.scal[(sid * 66 + j) * 2] = vec[1152 + d * 2];
      p.scal[(sid * 66 + j) * 2 + 1] = vec[1152 + d * 2 + 1];
    }
  }
  __syncthreads();
}

DEV void sgu_item(const Params& p, int l, int it, unsigned char* smem) {
  bf* sA = (bf*)smem;
  bf* sB = (bf*)(smem + OFF_SB);
  float* rstd = (float*)(smem + OFF_VEC);
  const int tid = otid();
  int g = it & 3, j = (it >> 2) % 66, bl = it / 264;
  size_t base = (size_t)bl * TB + j * 128;
  bf* Pb = p.P;
  const int rb = (int)base;
  {
    int t = tid >> 1, hh = tid & 1;
    float ss = 0.f;
    for (int i = 0; i < 32; i++) {
      uint4 u = *(const uint4*)(Pb + pidx(rb + t, CVS + hh * 256 + i * 8));
      float a;
      a = lo2f(u.x); ss += a * a; a = hi2f(u.x); ss += a * a;
      a = lo2f(u.y); ss += a * a; a = hi2f(u.y); ss += a * a;
      a = lo2f(u.z); ss += a * a; a = hi2f(u.z); ss += a * a;
      a = lo2f(u.w); ss += a * a; a = hi2f(u.w); ss += a * a;
    }
    ss += __shfl_xor(ss, 1);
    if (hh == 0) rstd[t] = rsqrtf(ss * (1.f / 512.f) + EPS);
  }
  __syncthreads();
  const bf* W = p.wsp + (size_t)(l * 4 + g) * 128 * 128;
  const float* gs = p.g_sgu + l * 512 + g * 128;
  f32x16 acc[2][2];
  auto gA = [&](int kt, int r, int ko) -> uint4 { return *(const uint4*)(W + r * 128 + kt * 64 + ko); };
  auto gB = [&](int kt, int to, int c) -> uint4 {
    int tok = kt * 64 + to;
    return scale8(*(const uint4*)(Pb + pidx(rb + tok, CVS + g * 128 + c)), rstd[tok]);
  };
  block_gemm<128, 128, 64, false, true, true>(acc, gA, gB, 2, sA, sB);
  const float* bs = p.b_sp + (size_t)(l * 4 + g) * 128;
  float* Hs = (float*)smem;
  acc_foreach<128, 128>(acc, [&](int t, int c, float v) { Hs[t * 132 + c] = v; });
  __syncthreads();
  {
    const int t = tid >> 1, hh = tid & 1;
    const float* hrow = Hs + t * 132 + hh * 64;
    const float* gp = gs + hh * 64;
    const float bt = bs[t];
#pragma unroll 2
    for (int i = 0; i < 8; i++) {
      bf* up = Pb + pidx(rb + t, CU + g * 128 + hh * 64 + i * 8);
      uint4 uu = *(const uint4*)up;
      uint4 uz = *(const uint4*)(Pb + pidx(rb + t, CZB + g * 128 + hh * 64 + i * 8));
      float4 h0 = *(const float4*)(hrow + i * 8), h1 = *(const float4*)(hrow + i * 8 + 4);
      float4 g0 = *(const float4*)(gp + i * 8), g1 = *(const float4*)(gp + i * 8 + 4);
      float y0 = lo2f(uu.x) * (h0.x * g0.x + bt) * silu(lo2f(uz.x));
      float y1 = hi2f(uu.x) * (h0.y * g0.y + bt) * silu(hi2f(uz.x));
      float y2 = lo2f(uu.y) * (h0.z * g0.z + bt) * silu(lo2f(uz.y));
      float y3 = hi2f(uu.y) * (h0.w * g0.w + bt) * silu(hi2f(uz.y));
      float y4 = lo2f(uu.z) * (h1.x * g1.x + bt) * silu(lo2f(uz.z));
      float y5 = hi2f(uu.z) * (h1.y * g1.y + bt) * silu(hi2f(uz.z));
      float y6 = lo2f(uu.w) * (h1.z * g1.z + bt) * silu(lo2f(uz.w));
      float y7 = hi2f(uu.w) * (h1.w * g1.w + bt) * silu(hi2f(uz.w));
      *(uint4*)up = make_uint4(pack2(y0, y1), pack2(y2, y3), pack2(y4, y5), pack2(y6, y7));
    }
  }
  __syncthreads();
}

DEV void fourA_item(const Params& p, int it, unsigned char* smem) {
  bf* sA = (bf*)smem;
  bf* sB = (bf*)(smem + OFF_SB);
  int cht = it & 3, t2 = (it >> 2) & 127, bl = it >> 9;
  const bf* Pb = p.P;
  const int rb = bl * TB + 256 + t2;
  f32x16 acc[2][2];
  auto gA = [&](int kt, int r, int ko) -> uint4 { return *(const uint4*)(p.m1 + r * 128 + kt * 64 + ko); };
  auto gB = [&](int kt, int to, int c) -> uint4 {
    int ri = kt, t1 = to;
    return *(const uint4*)(Pb + pidx(rb + t1 * 128, (ri ? CHI : CHR) + cht * 128 + c));
  };
  block_gemm<128, 128, 64, false, true, true>(acc, gA, gB, 2, sA, sB);
  float* Ha = (float*)smem;
  acc_foreach<128, 128>(acc, [&](int m, int c, float v) { Ha[m * 132 + c] = v; });
  __syncthreads();
  {
    const int tid = otid();
    const int k1 = tid >> 2, cq = (tid & 3) * 32;
    const float* ar = Ha + ((k1 >> 5) * 64 + (k1 & 31)) * 132 + cq;
    const float* ai = ar + 32 * 132;
    const float c = p.tw[(t2 * 64 + k1) * 2], sn = p.tw[(t2 * 64 + k1) * 2 + 1];
    bf* ore = p.abuf + ((((((size_t)bl * 64 + k1) * 4 + cht) * 2) * 128 + t2) * 128) + cq;
    bf* oim = ore + (size_t)128 * 128;
#pragma unroll
    for (int i = 0; i < 4; i++) {
      float4 r0 = *(const float4*)(ar + i * 8), r1 = *(const float4*)(ar + i * 8 + 4);
      float4 i0 = *(const float4*)(ai + i * 8), i1 = *(const float4*)(ai + i * 8 + 4);
      *(uint4*)(ore + i * 8) = make_uint4(pack2(r0.x * c + i0.x * sn, r0.y * c + i0.y * sn), pack2(r0.z * c + i0.z * sn, r0.w * c + i0.w * sn),
                                          pack2(r1.x * c + i1.x * sn, r1.y * c + i1.y * sn), pack2(r1.z * c + i1.z * sn, r1.w * c + i1.w * sn));
      *(uint4*)(oim + i * 8) = make_uint4(pack2(i0.x * c - r0.x * sn, i0.y * c - r0.y * sn), pack2(i0.z * c - r0.z * sn, i0.w * c - r0.w * sn),
                                          pack2(i1.x * c - r1.x * sn, i1.y * c - r1.y * sn), pack2(i1.z * c - r1.z * sn, i1.w * c - r1.w * sn));
    }
  }
  __syncthreads();
}

DEV void fourCtx_item(const Params& p, int l, int it, unsigned char* smem) {
  bf* sA = (bf*)smem;
  bf* sB = (bf*)(smem + OFF_SB);
  int mt = it & 1, g = (it >> 1) & 3, bl = it >> 3;
  const bf* Pb = p.P;
  const int rb = bl * TB;
  f32x16 acc[2][2];
  auto gA = [&](int kt, int r, int ko) -> uint4 { return *(const uint4*)(p.mctx + (mt * 128 + r) * 512 + kt * 64 + ko); };
  auto gB = [&](int kt, int to, int c) -> uint4 {
    int ri = kt >> 2, t = (kt & 3) * 64 + to;
    return *(const uint4*)(Pb + pidx(rb + t, (ri ? CHI : CHR) + g * 128 + c));
  };
  block_gemm<128, 128, 64, false, true, true>(acc, gA, gB, 8, sA, sB);
  float* Hs = (float*)smem;
  acc_foreach<128, 128>(acc, [&](int tl, int d, float v) { Hs[tl * 132 + d] = v; });
  __syncthreads();
  {
    const int tid = otid();
    const int tl = tid >> 1, hh = tid & 1;
    const int tp = mt * 128 + tl;
    const float* hrow = Hs + tl * 132 + hh * 64;
    const float* bp = p.b_fno + l * 512 + g * 128 + hh * 64;
    bf* op = p.cbuf + ((size_t)bl * 256 + tp) * 512 + g * 128 + hh * 64;
#pragma unroll 2
    for (int i = 0; i < 8; i++) {
      uint4 uz = *(const uint4*)(Pb + pidx(rb + tp, CZC + g * 128 + hh * 64 + i * 8));
      float4 h0 = *(const float4*)(hrow + i * 8), h1 = *(const float4*)(hrow + i * 8 + 4);
      float4 b0 = *(const float4*)(bp + i * 8), b1 = *(const float4*)(bp + i * 8 + 4);
      float y0 = (h0.x * 0.0625f + b0.x) * silu(lo2f(uz.x)), y1 = (h0.y * 0.0625f + b0.y) * silu(hi2f(uz.x));
      float y2 = (h0.z * 0.0625f + b0.z) * silu(lo2f(uz.y)), y3 = (h0.w * 0.0625f + b0.w) * silu(hi2f(uz.y));
      float y4 = (h1.x * 0.0625f + b1.x) * silu(lo2f(uz.z)), y5 = (h1.y * 0.0625f + b1.y) * silu(hi2f(uz.z));
      float y6 = (h1.z * 0.0625f + b1.z) * silu(lo2f(uz.w)), y7 = (h1.w * 0.0625f + b1.w) * silu(hi2f(uz.w));
      *(uint4*)(op + i * 8) = make_uint4(pack2(y0, y1), pack2(y2, y3), pack2(y4, y5), pack2(y6, y7));
    }
  }
  __syncthreads();
}

DEV void phase3(const Params& p, int l, unsigned char* smem) {
  const int n0 = 1056, n1 = n0 + 528, n2 = n1 + 1024, n3 = n2 + 16;
  for (int it = obid(); it < n3; it += gridDim.x) {
    if (it < n0) mlstm_dc_item(p, it, smem);
    else if (it < n1) sgu_item(p, l, it - n0, smem);
    else if (it < n2) fourA_item(p, it - n1, smem);
    else fourCtx_item(p, l, it - n2, smem);
  }
}

DEV int chunk_at(int d, int pp) { return d ? (pp == 0 ? 1 : (pp == 1 ? 0 : 67 - pp)) : pp; }
DEV void scan_item(const Params& p, int it, unsigned char* smem) {
  float* tab = (float*)(smem + OFF_VEC);
  const int tid = otid();
  int eb = it & 15, sid = it >> 4;
  int d = sid & 1;
  if (tid < 66) {
    int j = chunk_at(d, tid);
    tab[256 + tid] = p.scal[(sid * 66 + j) * 2];
    tab[384 + tid] = p.scal[(sid * 66 + j) * 2 + 1];
  }
  __syncthreads();
  if (tid == 0) {
    float m = 0.f;
    for (int pp = 0; pp < 66; pp++) {
      float bl_ = tab[256 + pp], ml = tab[384 + pp];
      float mn = fmaxf(bl_ + m, ml);
      tab[pp] = __expf(bl_ + m - mn);
      tab[128 + pp] = __expf(ml - mn);
      if (eb == 0) p.mstart[sid * 66 + chunk_at(d, pp)] = m;
      m = mn;
    }
  }
  __syncthreads();
  {
    float v0 = 0.f, v1 = 0.f;
    unsigned* basep = (unsigned*)(p.states + (size_t)sid * 66 * 8192) + eb * 256 + tid;
#pragma unroll 1
    for (int pb = 0; pb < 66; pb += 33) {
      unsigned dv[33];
#pragma unroll
      for (int u = 0; u < 33; u++) dv[u] = basep[(size_t)chunk_at(d, pb + u) * 4096];
#pragma unroll
      for (int u = 0; u < 33; u++) {
        basep[(size_t)chunk_at(d, pb + u) * 4096] = pack2(v0, v1);
        float de = tab[pb + u], sc = tab[128 + pb + u];
        v0 = de * v0 + sc * lo2f(dv[u]);
        v1 = de * v1 + sc * hi2f(dv[u]);
      }
    }
  }
  if (eb == 0 && tid < 64) {
    float val = 0.f;
    float* basep = p.nbuf + (size_t)sid * 66 * 64 + tid;
#pragma unroll 1
    for (int pb = 0; pb < 66; pb += 33) {
      float dv[33];
#pragma unroll
      for (int u = 0; u < 33; u++) dv[u] = basep[chunk_at(d, pb + u) * 64];
#pragma unroll
      for (int u = 0; u < 33; u++) {
        basep[chunk_at(d, pb + u) * 64] = val;
        val = tab[pb + u] * val + tab[128 + pb + u] * dv[u];
      }
    }
  }
  __syncthreads();
}

DEV void fourC_item(const Params& p, int l, int it, unsigned char* smem) {
  bf* sA = (bf*)smem;
  bf* sB = (bf*)(smem + OFF_SB);
  int g = it & 3, k1 = (it >> 2) & 63, bl = it >> 8;
  const bf* Ab = p.abuf + ((((size_t)bl * 64 + k1) * 4 + g) * 2) * 128 * 128;
  f32x16 acc[2][2];
  auto gA = [&](int kt, int r, int ko) -> uint4 { return *(const uint4*)(p.m2 + r * 256 + kt * 64 + ko); };
  auto gB = [&](int kt, int to, int c) -> uint4 {
    int kk = kt * 64 + to;
    return *(const uint4*)(Ab + (unsigned)(kk * 128 + c));
  };
  block_gemm<128, 128, 64, false, true, true>(acc, gA, gB, 4, sA, sB);
  bf* Pb = p.P;
  const int rb = bl * TB + 256;
  float* Hs = (float*)smem;
  acc_foreach<128, 128>(acc, [&](int k2, int d, float v) { Hs[k2 * 132 + d] = v; });
  __syncthreads();
  {
    const int tid = otid();
    const int k2 = tid >> 1, hh = tid & 1;
    const int tp = k1 + 64 * k2;
    const float* hrow = Hs + k2 * 132 + hh * 64;
    const float* bp = p.b_fno + l * 512 + g * 128 + hh * 64;
    const float sc = 0.011048543456039806f;
#pragma unroll 2
    for (int i = 0; i < 8; i++) {
      uint4 uz = *(const uint4*)(Pb + pidx(rb + tp, CZC + g * 128 + hh * 64 + i * 8));
      bf* op = Pb + pidx(rb + tp, CHR + g * 128 + hh * 64 + i * 8);
      float4 h0 = *(const float4*)(hrow + i * 8), h1 = *(const float4*)(hrow + i * 8 + 4);
      float4 b0 = *(const float4*)(bp + i * 8), b1 = *(const float4*)(bp + i * 8 + 4);
      float y0 = (h0.x * sc + b0.x) * silu(lo2f(uz.x)), y1 = (h0.y * sc + b0.y) * silu(hi2f(uz.x));
      float y2 = (h0.z * sc + b0.z) * silu(lo2f(uz.y)), y3 = (h0.w * sc + b0.w) * silu(hi2f(uz.y));
      float y4 = (h1.x * sc + b1.x) * silu(lo2f(uz.z)), y5 = (h1.y * sc + b1.y) * silu(hi2f(uz.z));
      float y6 = (h1.z * sc + b1.z) * silu(lo2f(uz.w)), y7 = (h1.w * sc + b1.w) * silu(hi2f(uz.w));
      *(uint4*)op = make_uint4(pack2(y0, y1), pack2(y2, y3), pack2(y4, y5), pack2(y6, y7));
    }
  }
  __syncthreads();
}

DEV void phase4(const Params& p, int l, unsigned char* smem) {
  const int n0 = 512, n1 = n0 + 32 * 16;
  for (int it = obid(); it < n1; it += gridDim.x) {
    if (it < n0) fourC_item(p, l, it, smem);
    else scan_item(p, it - n0, smem);
  }
  for (int i = obid() * 256 + otid(); i < 2 * 256 * 512; i += gridDim.x * 256) {
    int c = i & 511, t = (i >> 9) & 255, bl = i >> 17;
    p.P[pidx(bl * TB + t, CHR + c)] = p.cbuf[i];
  }
}

DEV void mlstm_out_item(const Params& p, int l, int it, unsigned char* smem) {
  bf* sA = (bf*)smem;
  bf* sB = (bf*)(smem + OFF_SB32);
  bf* Sl = (bf*)(smem + OFF_SL);
  float* vec = (float*)(smem + OFF_VEC);
  float* mrow = vec + 768;
  float* winter = vec + 896;
  float* dinv = vec + 1024;
  float* nst = vec + 1160;
  const int tid = otid(), lane = tid & 63, w = tid >> 6, wm = w >> 1, wn = w & 1;
  int j, h, bl;
  if (l == 0) { j = it % 66; h = (it / 66) & 7; bl = it / 528; }
  else { j = 2 + (it & 63); h = (it >> 6) & 7; bl = it >> 9; }
  size_t base = (size_t)bl * TB + j * 128;
  gate_prep(p.gates + base * 32, h, vec, false);
  bf* Pb = p.P;
  const int rb = (int)base;
  f32x16 acch[2][2];
  for (int d = 0; d < 2; d++) {
    int sid = (bl * 8 + h) * 2 + d;
    const bf* slot = p.states + ((size_t)sid * 66 + j) * 8192;
    const float* nslot = p.nbuf + ((size_t)sid * 66 + j) * 64;
    const float* igv = vec + d * 128;
    const float* bv = vec + 256 + d * 128;
    const float* pmv = vec + 512 + d * 128;
    float ms = p.mstart[sid * 66 + j];
    if (tid < 128) {
      float inter = bv[tid] + ms;
      float mr = fmaxf(inter, bv[tid] + pmv[tid]);
      mrow[tid] = mr;
      winter[tid] = __expf(inter - mr);
    } else if (tid < 192) {
      nst[tid - 128] = nslot[tid - 128];
    }
    __syncthreads();
    {
      f32x16 acc[2][2];
      auto gA = [&](int kt, int r, int ko) -> uint4 { return *(const uint4*)(Pb + pidx(rb + r, CQ + h * 64 + ko)); };
      auto gB = [&](int kt, int r, int ko) -> uint4 { return *(const uint4*)(Pb + pidx(rb + r, CK + h * 64 + ko)); };
      block_gemm<128, 128, 64, false, false>(acc, gA, gB, 1, sA, sB);
      acc_foreach<128, 128>(acc, [&](int t, int s, float v) { Sl[t * 136 + s] = f2bf(v); });
    }
    __syncthreads();
#pragma unroll 1
    for (int i = 0; i < 8; i++) {
      int idx = tid + 256 * i;
      int t = idx >> 4, s0 = (idx & 15) * 8;
      uint4 u = *(const uint4*)(Sl + t * 136 + s0);
      float rowc = bv[t] - mrow[t];
      float4 b0 = *(const float4*)(bv + s0), b1 = *(const float4*)(bv + s0 + 4);
      float4 g0 = *(const float4*)(igv + s0), g1 = *(const float4*)(igv + s0 + 4);
      float e[8];
      e[0] = lo2f(u.x) * __expf(rowc - b0.x + g0.x); e[1] = hi2f(u.x) * __expf(rowc - b0.y + g0.y);
      e[2] = lo2f(u.y) * __expf(rowc - b0.z + g0.z); e[3] = hi2f(u.y) * __expf(rowc - b0.w + g0.w);
      e[4] = lo2f(u.z) * __expf(rowc - b1.x + g1.x); e[5] = hi2f(u.z) * __expf(rowc - b1.y + g1.y);
      e[6] = lo2f(u.w) * __expf(rowc - b1.z + g1.z); e[7] = hi2f(u.w) * __expf(rowc - b1.w + g1.w);
#pragma unroll
      for (int q = 0; q < 8; q++) {
        int sq = s0 + q;
        bool ok = d ? (sq >= t) : (sq <= t);
        e[q] = ok ? 0.125f * e[q] : 0.f;
      }
      *(uint4*)(Sl + t * 136 + s0) = make_uint4(pack2(e[0], e[1]), pack2(e[2], e[3]), pack2(e[4], e[5]), pack2(e[6], e[7]));
    }
    __syncthreads();
    {
      int t = tid >> 1, hh = tid & 1;
      float rs = 0.f, qn = 0.f;
#pragma unroll
      for (int i = 0; i < 8; i++) {
        uint4 u = *(const uint4*)(Sl + t * 136 + hh * 64 + i * 8);
        rs += lo2f(u.x) + hi2f(u.x) + lo2f(u.y) + hi2f(u.y) + lo2f(u.z) + hi2f(u.z) + lo2f(u.w) + hi2f(u.w);
      }
      const bf* qp = Pb + pidx(rb + t, CQ + h * 64 + hh * 32);
      const float* np_ = nst + hh * 32;
#pragma unroll
      for (int i = 0; i < 4; i++) {
        uint4 u = *(const uint4*)(qp + i * 8);
        qn += lo2f(u.x) * np_[i * 8 + 0] + hi2f(u.x) * np_[i * 8 + 1] + lo2f(u.y) * np_[i * 8 + 2] + hi2f(u.y) * np_[i * 8 + 3] +
              lo2f(u.z) * np_[i * 8 + 4] + hi2f(u.z) * np_[i * 8 + 5] + lo2f(u.w) * np_[i * 8 + 6] + hi2f(u.w) * np_[i * 8 + 7];
      }
      rs += __shfl_xor(rs, 1);
      qn += __shfl_xor(qn, 1);
      if (hh == 0) {
        float den = rs + winter[t] * 0.125f * qn;
        dinv[t] = 1.f / fmaxf(fabsf(den), __expf(-mrow[t]));
      }
    }
    __syncthreads();
    {
      auto gA = [&](int kt, int r, int ko) -> uint4 {
        if (kt < 4) return scale8(*(const uint4*)(Sl + r * 136 + kt * 32 + ko), dinv[r]);
        uint4 q = *(const uint4*)(Pb + pidx(rb + r, CQ + h * 64 + (kt - 4) * 32 + ko));
        return scale8(q, winter[r] * 0.125f * dinv[r]);
      };
      auto gB = [&](int kt, int to, int c) -> uint4 {
        if (kt < 4) return *(const uint4*)(Pb + pidx(rb + kt * 32 + to, CV + h * 128 + c));
        return *(const uint4*)(slot + ((kt - 4) * 32 + to) * 128 + c);
      };
      block_gemm<128, 128, 32, false, true, true>(acch, gA, gB, 6, sA, sB, d == 0);
    }
    __syncthreads();
  }
  float* Hs = (float*)smem;
  acc_foreach<128, 128>(acch, [&](int t, int c, float v) { Hs[t * 132 + c] = v; });
  __syncthreads();
  {
    const int t = tid >> 1, hh = tid & 1;
    const float* hrow = Hs + t * 132 + hh * 64;
    float ss = 0.f;
#pragma unroll 4
    for (int i = 0; i < 16; i++) {
      float4 v = *(const float4*)(hrow + i * 4);
      ss += v.x * v.x + v.y * v.y + v.z * v.z + v.w * v.w;
    }
    ss += __shfl_xor(ss, 1);
    const float rstd = rsqrtf(ss * (1.f / 128.f) + EPS);
    const float* gh = p.g_hnorm + l * D + h * 128 + hh * 64;
#pragma unroll 2
    for (int i = 0; i < 8; i++) {
      bf* op = Pb + pidx(rb + t, CO + h * 128 + hh * 64 + i * 8);
      uint4 uo = *(const uint4*)op;
      uint4 uz = *(const uint4*)(Pb + pidx(rb + t, CZA + h * 128 + hh * 64 + i * 8));
      float4 h0 = *(const float4*)(hrow + i * 8), h1 = *(const float4*)(hrow + i * 8 + 4);
      float4 g0 = *(const float4*)(gh + i * 8), g1 = *(const float4*)(gh + i * 8 + 4);
      float y0 = h0.x * rstd * g0.x * sigm(lo2f(uo.x)) * silu(lo2f(uz.x));
      float y1 = h0.y * rstd * g0.y * sigm(hi2f(uo.x)) * silu(hi2f(uz.x));
      float y2 = h0.z * rstd * g0.z * sigm(lo2f(uo.y)) * silu(lo2f(uz.y));
      float y3 = h0.w * rstd * g0.w * sigm(hi2f(uo.y)) * silu(hi2f(uz.y));
      float y4 = h1.x * rstd * g1.x * sigm(lo2f(uo.z)) * silu(lo2f(uz.z));
      float y5 = h1.y * rstd * g1.y * sigm(hi2f(uo.z)) * silu(hi2f(uz.z));
      float y6 = h1.z * rstd * g1.z * sigm(lo2f(uo.w)) * silu(lo2f(uz.w));
      float y7 = h1.w * rstd * g1.w * sigm(hi2f(uo.w)) * silu(hi2f(uz.w));
      *(uint4*)op = make_uint4(pack2(y0, y1), pack2(y2, y3), pack2(y4, y5), pack2(y6, y7));
    }
  }
  __syncthreads();
}

DEV void phase6(const Params& p, int l, unsigned char* smem) {
  bf* sA = (bf*)smem;
  bf* sB = (bf*)(smem + OFF_SB);
  const int bid = obid();
  const int nxb = gridDim.x >> 3, xcd = bid & 7, lb = bid >> 3;
  if (l == 1) {
    bf* sA2 = (bf*)smem;
    bf* sB2 = (bf*)(smem + 40960);
    for (int t = xcd * 64 + lb; t < (xcd + 1) * 64; t += nxb) {
      int m256 = (t >> 6) * 8 + (t & 7), nt = (t >> 3) & 7;
      int rowbase = (m256 >> 5) * TB + 256 + (m256 & 31) * 256;
      const bf* A = p.P;
      const bf* B = p.wt_out + ((size_t)l * D + nt * 128) * 2048;
      f32x16 acc[4][2];
      auto gA = [&](int kt, int r, int ko) -> uint4 {
        int k = kt * 32;
        int col = (kt < 32 ? CO + k : (kt < 48 ? CU + (k - 1024) : CHR + (k - 1536))) + ko;
        return *(const uint4*)(A + pidx(rowbase + r, col));
      };
      auto gB = [&](int kt, int r, int ko) -> uint4 { return *(const uint4*)(B + (unsigned)(r * 2048 + kt * 32 + ko)); };
      block_gemm<256, 128, 32, false, false, true>(acc, gA, gB, 64, sA2, sB2);
      bf* Yt = p.ybuf + (size_t)rowbase * D + nt * 128;
      store_tile_bf16<256>(acc, (bf*)smem, [&](int row) -> bf* { return Yt + (unsigned)(row * D); }, 128);
    }
    return;
  }
  const int nmt = (l == 0) ? 132 : 128;
  const int per = nmt;
  for (int t = xcd * per + lb; t < (xcd + 1) * per; t += nxb) {
    int mtl, nt;
    if (t < 1024) { mtl = (t >> 6) * 8 + (t & 7); nt = (t >> 3) & 7; }
    else { mtl = 128 + ((t - 1024) & 3); nt = (t - 1024) >> 2; }
    int rowbase = (l == 0) ? mtl * 128 : ((mtl >> 6) * TB + 256 + (mtl & 63) * 128);
    const int mt = rowbase >> 7;
    const bf* A = p.P;
    const bf* B = p.wt_out + ((size_t)l * D + nt * 128) * 2048;
    f32x16 acc[2][2];
    auto gA = [&](int kt, int r, int ko) -> uint4 {
      int k = kt * 64;
      int col = (kt < 16 ? CO + k : (kt < 24 ? CU + (k - 1024) : CHR + (k - 1536))) + ko;
      return *(const uint4*)(A + pidx(rowbase + r, col));
    };
    auto gB = [&](int kt, int r, int ko) -> uint4 { return *(const uint4*)(B + (unsigned)(r * 2048 + kt * 64 + ko)); };
    block_gemm<128, 128, 64, false, false, true>(acc, gA, gB, 32, sA, sB);
    bf* Yt = p.ybuf + (size_t)mt * 128 * D + nt * 128;
    store_tile_bf16<128>(acc, (bf*)smem, [&](int row) -> bf* { return Yt + (unsigned)(row * D); }, 128);
  }
}

DEV void phase7(const Params& p, int l, int hf) {
  const int lane = otid() & 63, w = otid() >> 6;
  for (int rl = obid() * 4 + w; rl < HROWS; rl += gridDim.x * 4) {
    int r = hf * HROWS + rl;
    int b = r / TB, j = r % TB;
    const float* xin;
    float* xo;
    int mv;
    if (j < 256) {
      if (l != 0) continue;
      xin = p.ctx + ((size_t)b * 256 + j) * D;
      xo = p.xc1 + ((size_t)b * 256 + j) * D;
      mv = 4;
    } else {
      xin = (l == 0 ? p.x : p.out) + ((size_t)b * 8192 + (j - 256)) * D;
      xo = p.out + ((size_t)b * 8192 + (j - 256)) * D;
      mv = b;
    }
    const float* gt = p.mod + (size_t)(l * 5 + mv) * 3072 + 2048;
    const bf* yp = p.ybuf + (size_t)rl * D;
    float y[16];
    float ss = 0.f;
#pragma unroll
    for (int i = 0; i < 4; i++) {
      uint2 u = *(const uint2*)(yp + lane * 4 + 256 * i);
      y[i * 4 + 0] = lo2f(u.x); y[i * 4 + 1] = hi2f(u.x); y[i * 4 + 2] = lo2f(u.y); y[i * 4 + 3] = hi2f(u.y);
      ss += y[i * 4] * y[i * 4] + y[i * 4 + 1] * y[i * 4 + 1] + y[i * 4 + 2] * y[i * 4 + 2] + y[i * 4 + 3] * y[i * 4 + 3];
    }
#pragma unroll
    for (int off = 32; off; off >>= 1) ss += __shfl_xor(ss, off);
    float rstd = rsqrtf(ss * (1.f / 1024.f) + EPS);
#pragma unroll
    for (int i = 0; i < 4; i++) {
      int col = lane * 4 + 256 * i;
      float4 xv = nt_load4(xin + col);
      float4 g = *(const float4*)(p.g_post + l * D + col);
      float4 gv = *(const float4*)(gt + col);
      float4 o;
      o.x = xv.x + gv.x * (y[i * 4 + 0] * rstd * g.x);
      o.y = xv.y + gv.y * (y[i * 4 + 1] * rstd * g.y);
      o.z = xv.z + gv.z * (y[i * 4 + 2] * rstd * g.z);
      o.w = xv.w + gv.w * (y[i * 4 + 3] * rstd * g.w);
      nt_store4(xo + col, o);
    }
  }
}


#define XB_TMO      128
#define XB_XCNT(j)  (256  + 64 * (j))
#define XB_XSUB(j)  (1280 + 64 * (j))
#define XB_XGEN(j)  (2304 + 64 * (j))
#define XB_TOP      3328
#define XB_TOPGEN   3392
#define XCD_BAR_WORDS 3456
#define XB_SPIN_CAP (1u << 18)
#define LAS __attribute__((address_space(3)))
DEV unsigned xb_ld(unsigned* p) { return __hip_atomic_load(p, __ATOMIC_RELAXED, __HIP_MEMORY_SCOPE_AGENT); }
DEV unsigned xb_add(unsigned* p, unsigned v) { return __hip_atomic_fetch_add(p, v, __ATOMIC_RELAXED, __HIP_MEMORY_SCOPE_AGENT); }
DEV unsigned xb_xcc_id() { return (unsigned)__builtin_amdgcn_s_getreg((3 << 11) | 20) & 0xFu; }
#define XB_SPIN(cond, bar) do { unsigned _sp = 0; while (cond) { __builtin_amdgcn_s_sleep(1); \
    if ((++_sp & 255u) == 0u) { if (xb_ld(&(bar)[XB_TMO])) break; if (_sp > XB_SPIN_CAP) { atomicAdd(&(bar)[XB_TMO], 1u); break; } } } } while (0)
struct XcdBarrier {
  unsigned* bar;
  unsigned x;
  volatile LAS unsigned* st;
};
DEV XcdBarrier xcd_barrier_post(unsigned* bar, volatile LAS unsigned* st) {
  XcdBarrier b;
  b.bar = bar;
  b.x = xb_xcc_id();
  b.st = st;
  if (threadIdx.x == 0) (void)xb_add(&bar[XB_XCNT(b.x)], 1u);
  return b;
}
DEV void xcd_barrier_complete(unsigned* bar, unsigned x, unsigned& nloc, unsigned& nx) {
  const unsigned G = gridDim.x * gridDim.y * gridDim.z;
  unsigned sum, cnt, mine, sp = 0u;
  for (;;) {
    sum = 0u; cnt = 0u; mine = 0u;
#pragma unroll
    for (unsigned j = 0; j < 16; ++j) {
      const unsigned c = xb_ld(&bar[XB_XCNT(j)]);
      sum += c;
      cnt += (c > 0u) ? 1u : 0u;
      mine = (j == x) ? c : mine;
    }
    if (sum == G) break;
    __builtin_amdgcn_s_sleep(1);
    if ((++sp & 255u) == 0u) {
      if (xb_ld(&bar[XB_TMO])) break;
      if (sp > XB_SPIN_CAP) { atomicAdd(&bar[XB_TMO], 1u); break; }
    }
  }
  nloc = mine > 0u ? mine : 1u;
  nx = cnt > 0u ? cnt : 1u;
}
DEV void xcd_barrier(const XcdBarrier& b) {
  asm volatile("s_waitcnt vmcnt(0)" ::: "memory");
  __syncthreads();
  if (threadIdx.x == 0) {
    unsigned* bar = b.bar;
    __builtin_amdgcn_s_waitcnt(0);
    unsigned nloc = b.st[0], nx = b.st[1];
    if (nloc == 0u) {
      xcd_barrier_complete(bar, b.x, nloc, nx);
      b.st[0] = nloc;
      b.st[1] = nx;
    }
    const unsigned old = xb_add(&bar[XB_XSUB(b.x)], 1u);
    const unsigned gen = old / nloc;
    if (old + 1u == (gen + 1u) * nloc) {
      __builtin_amdgcn_fence(__ATOMIC_RELEASE, "agent");
      asm volatile("s_waitcnt vmcnt(0)" ::: "memory");
      const unsigned og = xb_add(&bar[XB_TOP], 1u);
      const unsigned tg = og / nx;
      if (og + 1u == (tg + 1u) * nx) xb_add(&bar[XB_TOPGEN], 1u);
      else XB_SPIN(xb_ld(&bar[XB_TOPGEN]) == tg, bar);
      __builtin_amdgcn_fence(__ATOMIC_ACQUIRE, "agent");
      xb_add(&bar[XB_XGEN(b.x)], 1u);
      asm volatile("s_waitcnt vmcnt(0)" ::: "memory");
    } else {
      XB_SPIN(xb_ld(&bar[XB_XGEN(b.x)]) == gen, bar);
      __builtin_amdgcn_fence(__ATOMIC_ACQUIRE, "agent");
      asm volatile("s_waitcnt vmcnt(0)" ::: "memory");
    }
  }
  __syncthreads();
}

__global__ void __launch_bounds__(256, 2) mk_forward(Params p) {
  extern __shared__ __attribute__((aligned(16))) unsigned char smem[];
  cg::grid_group grid = cg::this_grid();
  volatile LAS unsigned* xst = (volatile LAS unsigned*)(smem + LDS_BYTES - 16);
  if (threadIdx.x == 0) { xst[0] = 0u; xst[1] = 0u; xst[2] = 0u; xst[3] = 0u; }
  __syncthreads();
  XcdBarrier xb = xcd_barrier_post(p.bar, xst);
  phase0a(p, smem);
  if (p.bar == nullptr) grid.sync();
  xcd_barrier(xb);
  phase0b(p, smem);
  phase1(p, 0);
  xcd_barrier(xb);
  for (int l = 0; l < 2; l++) {
    for (int hf = 0; hf < 2; hf++) {
      if (hf == 0) {
        phase2(p, l, 0, smem);
        xcd_barrier(xb);
      }
      phase3(p, l, smem);
      xcd_barrier(xb);
      phase4(p, l, smem);
      xcd_barrier(xb);
      for (int it = obid(); it < (l == 0 ? 1056 : 1024); it += gridDim.x) mlstm_out_item(p, l, it, smem);
      xcd_barrier(xb);
      phase6(p, l, smem);
      xcd_barrier(xb);
      phase7(p, l, hf);
      if (hf == 0) {
        phase2(p, l, 1, smem);
        xcd_barrier(xb);
      }
    }
    if (l == 0) {
      xcd_barrier(xb);
      phase1(p, 1);
      xcd_barrier(xb);
    }
  }
}

extern "C" void kernel_launch(void* const* d_in, const int* in_sizes, int n_in, void* d_out, int out_size, void* d_ws,
                              size_t ws_size, hipStream_t stream) {
  static int grid_blocks = 0;
  if (grid_blocks == 0) {
    int dev = 0, cus = 0, per_cu = 0;
    hipGetDevice(&dev);
    hipDeviceGetAttribute(&cus, hipDeviceAttributeMultiprocessorCount, dev);
    if (hipFuncSetAttribute((const void*)mk_forward, hipFuncAttributeMaxDynamicSharedMemorySize, LDS_BYTES) != hipSuccess) {
      fprintf(stderr, "hipFuncSetAttribute failed\n");
    }
    if (hipOccupancyMaxActiveBlocksPerMultiprocessor(&per_cu, (const void*)mk_forward, 256, LDS_BYTES) != hipSuccess || per_cu < 1) {
      fprintf(stderr, "occupancy query failed (%d)\n", per_cu);
      per_cu = 1;
    }
    (void)hipGetLastError();
    if (per_cu > 2) per_cu = 2;
    grid_blocks = cus * per_cu;
  }
  Params p{};
  p.x = (const float*)d_in[0]; p.c = (const float*)d_in[1]; p.ctx = (const float*)d_in[2]; p.c_ctx = (const float*)d_in[3];
  p.w_mod = (const float*)d_in[4]; p.b_mod = (const float*)d_in[5]; p.g_pre = (const float*)d_in[6];
  p.g_post = (const float*)d_in[7]; p.w_in = (const float*)d_in[8]; p.b_gate = (const float*)d_in[9];
  p.g_hnorm = (const float*)d_in[10]; p.g_sgu = (const float*)d_in[11]; p.w_sp = (const float*)d_in[12];
  p.b_sp = (const float*)d_in[13]; p.w_fno = (const float*)d_in[14]; p.b_fno = (const float*)d_in[15];
  p.w_out = (const float*)d_in[16];
  p.out = (float*)d_out;
  size_t off = 0;
  unsigned char* ws = (unsigned char*)d_ws;
  auto take = [&](size_t bytes) -> void* {
    void* r = ws + off;
    off += (bytes + 255) & ~(size_t)255;
    return r;
  };
  p.wt_in = (bf*)take((size_t)2 * NPW * D * 2);
  p.wt_out = (bf*)take((size_t)2 * D * 2048 * 2);
  p.wsp = (bf*)take((size_t)2 * 4 * 128 * 128 * 2);
  p.m1 = (bf*)take(128 * 128 * 2);
  p.m2 = (bf*)take(128 * 256 * 2);
  p.mctx = (bf*)take(256 * 512 * 2);
  p.hN = (bf*)take((size_t)ROWS * D * 2);
  p.P = (bf*)take((size_t)57 * HROWS * 128 * 2);
  p.abuf = (bf*)take((size_t)2 * 64 * 2 * 128 * 512 * 2);
  p.ybuf = (bf*)take((size_t)HROWS * D * 2);
  p.cbuf = (bf*)take((size_t)2 * 256 * 512 * 2);
  p.mod = (float*)take(2 * 5 * 3072 * 4);
  p.tw = (float*)take(128 * 64 * 8);
  p.Q = (float*)take((size_t)2 * 4 * 128 * 256 * 4);
  p.gates = (float*)take((size_t)HROWS * 32 * 4);
  p.states = (bf*)take((size_t)32 * 66 * 8192 * 2);
  p.nbuf = (float*)take((size_t)32 * 66 * 64 * 4);
  p.scal = (float*)take(32 * 66 * 2 * 4);
  p.mstart = (float*)take(32 * 66 * 4);
  p.xc1 = (float*)take((size_t)1024 * 1024 * 4);
  p.bar = (unsigned*)take((size_t)XCD_BAR_WORDS * 4);
  if (off > ws_size) {
    fprintf(stderr, "workspace too small: need %zu have %zu\n", off, ws_size);
    return;
  }
  if (hipMemsetAsync(p.bar, 0, (size_t)XCD_BAR_WORDS * 4, stream) != hipSuccess) fprintf(stderr, "memset failed\n");
  void* args[] = {&p};
  hipError_t e = hipLaunchCooperativeKernel((const void*)mk_forward, dim3(grid_blocks), dim3(256), args, LDS_BYTES, stream);
  if (e != hipSuccess) fprintf(stderr, "cooperative launch failed: %s (grid %d)\n", hipGetErrorString(e), grid_blocks);
}
```

```cpp
#include <hip/hip_runtime.h>
#include <hip/hip_cooperative_groups.h>
#include <cstdio>
namespace cg = cooperative_groups;

typedef unsigned short bf;
typedef __attribute__((ext_vector_type(8))) short bf16x8;
typedef __attribute__((ext_vector_type(16))) float f32x16;

#define DEV __device__ __forceinline__

constexpr int D = 1024, TB = 8448, ROWS = 33792, HROWS = 16896;
constexpr int NP = 7200, NPW = 7296, NIN = 6688;
constexpr int CQ = 0, CK = 512, CV = 1024, CO = 2048, CZA = 3072, CU = 4096, CVS = 4608, CZB = 5120,
              CHR = 5632, CZC = 6144, CHI = 6656, CG = 7168;
constexpr int SRC_G = 2048, SRC_F = 5664;
constexpr int SSLOT = 8256;
constexpr float EPS = 1e-6f;
constexpr int BKP = 40;
constexpr int LDS_BYTES = 80896;
constexpr int OFF_SB = 36864, OFF_SB32 = 20480, OFF_SL = 40960, OFF_VEC = 75776;

struct Params {
  const float *x, *c, *ctx, *c_ctx, *w_mod, *b_mod, *g_pre, *g_post, *w_in, *b_gate, *g_hnorm, *g_sgu, *w_sp, *b_sp,
      *w_fno, *b_fno, *w_out;
  float* out;
  bf *wt_in, *wt_out, *wsp, *m1, *m2, *mctx, *hN, *P, *abuf, *ybuf, *cbuf, *states;
  float *mod, *tw, *Q, *gates, *nbuf, *scal, *mstart, *xc1;
  unsigned* bar;
};

typedef __attribute__((ext_vector_type(2))) __bf16 bf16x2_t;
typedef __attribute__((ext_vector_type(2))) float f32x2_t;
DEV unsigned pack2(float a, float b) {
  f32x2_t f = {a, b};
  bf16x2_t h = __builtin_convertvector(f, bf16x2_t);
  return __builtin_bit_cast(unsigned, h);
}
DEV bf f2bf(float f) { return (bf)(pack2(f, f) & 0xffffu); }
DEV float bf2f(bf h) { return __uint_as_float(((unsigned)h) << 16); }
DEV float lo2f(unsigned u) { return __uint_as_float(u << 16); }
DEV float hi2f(unsigned u) { return __uint_as_float(u & 0xffff0000u); }
DEV int otid() {
  int t = threadIdx.x;
  asm volatile("" : "+v"(t));
  return t;
}
DEV int obid() {
  int b = blockIdx.x;
  asm volatile("" : "+s"(b));
  return b;
}
DEV unsigned pidx(int row, int col) { return (unsigned)(((col >> 7) * HROWS + row) * 128 + (col & 127)); }
typedef __attribute__((ext_vector_type(4))) float f32x4v;
DEV float4 nt_load4(const float* p) {
  f32x4v v = __builtin_nontemporal_load((const f32x4v*)p);
  return make_float4(v[0], v[1], v[2], v[3]);
}
DEV void nt_store4(float* p, float4 o) {
  f32x4v v = {o.x, o.y, o.z, o.w};
  __builtin_nontemporal_store(v, (f32x4v*)p);
}
DEV float silu(float x) { return x * __builtin_amdgcn_rcpf(1.f + __expf(-x)); }
DEV float sigm(float x) { return __builtin_amdgcn_rcpf(1.f + __expf(-x)); }
DEV float logsigmoid(float x) { return fminf(x, 0.f) - log1pf(__expf(-fabsf(x))); }

typedef __attribute__((ext_vector_type(4))) unsigned u32x4;
typedef __attribute__((ext_vector_type(4))) short s16x4;
DEV bf16x8 tr_frag(const bf* p, int ld) {
  typedef __attribute__((address_space(3))) s16x4 lds_s16x4;
  s16x4 t0 = __builtin_amdgcn_ds_read_tr16_b64_v4i16((lds_s16x4*)p);
  s16x4 t1 = __builtin_amdgcn_ds_read_tr16_b64_v4i16((lds_s16x4*)(p + 4 * ld));
  bf16x8 f = {t0[0], t0[1], t0[2], t0[3], t1[0], t1[1], t1[2], t1[3]};
  return f;
}
template <int BM, int BN, int BK, bool ATOK, bool BTOK, bool PF2 = false, class FA, class FB>
DEV void block_gemm(f32x16 (&acc)[BM / 64][BN / 64], FA getA, FB getB, int nkt, bf* sA, bf* sB, bool zero = true) {
  constexpr int MT = BM / 64, NTl = BN / 64, KV = BK / 8, NA = BM * KV / 256, NB = BN * KV / 256;
  constexpr int LDK = BK + 8;
  constexpr int LDAT = BM + 8, LDBT = BN + 8;
  constexpr int XBUFA = ATOK ? BK * LDAT : BM * LDK, XBUFB = BTOK ? BK * LDBT : BN * LDK;
  const int tid = otid(), lane = tid & 63, w = tid >> 6, wm = w >> 1, wn = w & 1;
  uint4 ra[NA], rb[NB];
  if (zero) {
#pragma unroll
    for (int i = 0; i < MT; i++)
#pragma unroll
      for (int j = 0; j < NTl; j++)
#pragma unroll
        for (int r = 0; r < 16; r++) acc[i][j][r] = 0.f;
  }

#define BG_FETCH(kt, RA, RB)                                                          \
  {                                                                                   \
    _Pragma("unroll") for (int i = 0; i < NA; i++) {                                  \
      int idx = tid + 256 * i;                                                        \
      if (ATOK) RA[i] = getA((kt), idx / (BM / 8), (idx % (BM / 8)) * 8);              \
      else RA[i] = getA((kt), idx / KV, (idx % KV) * 8);                              \
    }                                                                                 \
    _Pragma("unroll") for (int i = 0; i < NB; i++) {                                  \
      int idx = tid + 256 * i;                                                        \
      if (BTOK) RB[i] = getB((kt), idx / (BN / 8), (idx % (BN / 8)) * 8);              \
      else RB[i] = getB((kt), idx / KV, (idx % KV) * 8);                              \
    }                                                                                 \
  }
#define BG_STASH(buf, RA, RB)                                                         \
  {                                                                                   \
    _Pragma("unroll") for (int i = 0; i < NA; i++) {                                  \
      int idx = tid + 256 * i;                                                        \
      if (ATOK) *(uint4*)(sA + (buf) * XBUFA + (idx / (BM / 8)) * LDAT + (idx % (BM / 8)) * 8) = RA[i]; \
      else *(uint4*)(sA + (buf) * XBUFA + (idx / KV) * LDK + (idx % KV) * 8) = RA[i];  \
    }                                                                                 \
    _Pragma("unroll") for (int i = 0; i < NB; i++) {                                  \
      int idx = tid + 256 * i;                                                        \
      if (BTOK) *(uint4*)(sB + (buf) * XBUFB + (idx / (BN / 8)) * LDBT + (idx % (BN / 8)) * 8) = RB[i]; \
      else *(uint4*)(sB + (buf) * XBUFB + (idx / KV) * LDK + (idx % KV) * 8) = RB[i];  \
    }                                                                                 \
  }
#define BG_COMPUTE(buf)                                                               \
  _Pragma("unroll") for (int ks = 0; ks < BK / 16; ks++) {                            \
    bf16x8 a[MT], b[NTl];                                                             \
    _Pragma("unroll") for (int i = 0; i < MT; i++) {                                  \
      if (ATOK) {                                                                     \
        a[i] = tr_frag(sA + (buf) * XBUFA + (ks * 16 + (lane >> 5) * 8 + ((lane & 15) >> 2)) * LDAT + wm * (BM / 2) + i * 32 + \
                       ((lane >> 4) & 1) * 16 + (lane & 3) * 4, LDAT);                \
      } else {                                                                        \
        a[i] = *(const bf16x8*)(sA + (buf) * XBUFA + (wm * (BM / 2) + i * 32 + (lane & 31)) * LDK + ks * 16 + (lane >> 5) * 8); \
      }                                                                               \
    }                                                                                 \
    _Pragma("unroll") for (int j = 0; j < NTl; j++) {                                 \
      if (BTOK) {                                                                     \
        b[j] = tr_frag(sB + (buf) * XBUFB + (ks * 16 + (lane >> 5) * 8 + ((lane & 15) >> 2)) * LDBT + wn * (BN / 2) + j * 32 + \
                       ((lane >> 4) & 1) * 16 + (lane & 3) * 4, LDBT);                \
      } else {                                                                        \
        b[j] = *(const bf16x8*)(sB + (buf) * XBUFB + (wn * (BN / 2) + j * 32 + (lane & 31)) * LDK + ks * 16 + (lane >> 5) * 8); \
      }                                                                               \
    }                                                                                 \
    _Pragma("unroll") for (int i = 0; i < MT; i++)                                    \
      _Pragma("unroll") for (int j = 0; j < NTl; j++)                                 \
        acc[i][j] = __builtin_amdgcn_mfma_f32_32x32x16_bf16(a[i], b[j], acc[i][j], 0, 0, 0); \
    if (!ATOK && !BTOK) __builtin_amdgcn_iglp_opt(0);                                 \
  }

  if (PF2) {
    uint4 ra2[NA], rb2[NB];
    BG_FETCH(0, ra, rb);
    BG_FETCH(1, ra2, rb2);
    BG_STASH(0, ra, rb);
    __syncthreads();
#pragma unroll 1
    for (int kt = 0; kt < nkt; kt += 2) {
      const int k2 = min(kt + 2, nkt - 1), k3 = min(kt + 3, nkt - 1);
      BG_FETCH(k2, ra, rb);
      BG_COMPUTE(0);
      BG_STASH(1, ra2, rb2);
      __syncthreads();
      BG_FETCH(k3, ra2, rb2);
      BG_COMPUTE(1);
      BG_STASH(0, ra, rb);
      __syncthreads();
    }
  } else {
    BG_FETCH(0, ra, rb);
    BG_STASH(0, ra, rb);
    __syncthreads();
#pragma unroll 1
    for (int kt = 0; kt < nkt; kt++) {
      const int buf = kt & 1;
      if (kt + 1 < nkt) BG_FETCH(kt + 1, ra, rb);
      BG_COMPUTE(buf);
      if (kt + 1 < nkt) BG_STASH(buf ^ 1, ra, rb);
      __syncthreads();
    }
  }
#undef BG_FETCH
#undef BG_STASH
#undef BG_COMPUTE
}

template <int BM, class FD>
DEV void store_tile_bf16(f32x16 (&acc)[BM / 64][2], bf* Cs, FD dst, int ncols_valid) {
  acc_foreach<BM, 128>(acc, [&](int row, int col, float v) { Cs[row * 136 + col] = f2bf(v); });
  __syncthreads();
  const int tid = otid();
#pragma unroll 4
  for (int i = 0; i < BM / 16; i++) {
    int idx = tid + 256 * i;
    int row = idx >> 4, c8 = (idx & 15) * 8;
    uint4 v = *(const uint4*)(Cs + row * 136 + c8);
    if (c8 < ncols_valid) *(uint4*)(dst(row) + c8) = v;
  }
  __syncthreads();
}

DEV uint4 scale8(uint4 q, float sc) {
  return make_uint4(pack2(lo2f(q.x) * sc, hi2f(q.x) * sc), pack2(lo2f(q.y) * sc, hi2f(q.y) * sc),
                    pack2(lo2f(q.z) * sc, hi2f(q.z) * sc), pack2(lo2f(q.w) * sc, hi2f(q.w) * sc));
}

template <int BM, int BN, class F>
DEV void acc_foreach(f32x16 (&acc)[BM / 64][BN / 64], F f) {
  const int tid_ = otid();
  const int lane = tid_ & 63, w = tid_ >> 6, wm = w >> 1, wn = w & 1;
#pragma unroll
  for (int i = 0; i < BM / 64; i++)
#pragma unroll
    for (int j = 0; j < BN / 64; j++)
#pragma unroll
      for (int r = 0; r < 16; r++) {
        int row = wm * (BM / 2) + i * 32 + (r & 3) + 8 * (r >> 2) + 4 * (lane >> 5);
        int col = wn * (BN / 2) + j * 32 + (lane & 31);
        f(row, col, acc[i][j][r]);
        if (r == 15) asm volatile("" ::: "memory");
      }
}

DEV void conv_tile(const float* __restrict__ src, int srcld, int sn0, int nvalid, bf* __restrict__ dst, int dstld, int n0, int k0,
                   float* tile) {
  const int tid = otid();
  {
    float4 v[4];
#pragma unroll
    for (int i = 0; i < 4; i++) {
      int idx = tid + 256 * i;
      int kk = idx >> 4, n4 = (idx & 15) * 4;
      v[i] = make_float4(0.f, 0.f, 0.f, 0.f);
      if (n4 < nvalid) v[i] = *(const float4*)(src + (size_t)(k0 + kk) * srcld + sn0 + n4);
    }
#pragma unroll
    for (int i = 0; i < 4; i++) {
      int idx = tid + 256 * i;
      int kk = idx >> 4, n4 = (idx & 15) * 4;
      tile[kk * 65 + n4] = v[i].x; tile[kk * 65 + n4 + 1] = v[i].y; tile[kk * 65 + n4 + 2] = v[i].z; tile[kk * 65 + n4 + 3] = v[i].w;
    }
  }
  __syncthreads();
#pragma unroll 4
  for (int i = 0; i < 16; i++) {
    int idx = tid + 256 * i;
    int nn = idx >> 6, kk = idx & 63;
    int n = n0 + nn;
    dst[(size_t)n * dstld + k0 + kk] = f2bf(tile[kk * 65 + nn]);
  }
  __syncthreads();
}

DEV void phase0a(const Params& p, unsigned char* smem) {
  const int tid = otid();
  float* fs = (float*)smem;
  for (int it = obid(); it < 2 * 114 * 16; it += gridDim.x) {
    int kt = it & 15, nt = (it >> 4) % 114, l = it / (114 * 16);
    const int n0 = nt * 64;
    int sn0 = n0, nvalid = 64;
    if (n0 < 2048) sn0 = n0;
    else if (n0 < CHR) sn0 = n0 + 32;
    else if (n0 < CZC) continue;
    else if (n0 < CHI) sn0 = n0 + 32;
    else if (n0 < CG) continue;
    else if (n0 == CG) { sn0 = SRC_G; nvalid = 32; }
    else { sn0 = 0; nvalid = 0; }
    conv_tile(p.w_in + (size_t)l * D * NIN, NIN, sn0, nvalid, p.wt_in + (size_t)l * NPW * D, D, n0, kt * 64, fs);
  }
  for (int it = obid(); it < 2 * 16 * 32; it += gridDim.x) {
    int kt = it & 31, nt = (it >> 5) & 15, l = it >> 9;
    conv_tile(p.w_out + (size_t)l * 2048 * D, D, nt * 64, 64, p.wt_out + (size_t)l * D * 2048, 2048, nt * 64, kt * 64, fs);
  }
  for (int it = obid(); it < 96; it += gridDim.x) {
    int l = it / 48, j0 = (it % 48) * 64;
    float* sc = fs;
    float* red = fs + 5 * 1024;
    for (int i = tid; i < 5 * 1024; i += 256) {
      int v = i >> 10, k = i & 1023;
      float cv = (v < 4) ? p.c[v * D + k] : p.c_ctx[k];
      sc[i] = silu(cv);
    }
    __syncthreads();
    int col = tid & 63, ks = tid >> 6;
    float a0 = 0, a1 = 0, a2 = 0, a3 = 0, a4 = 0;
    const float* wp = p.w_mod + (size_t)l * D * 3072 + j0 + col;
#pragma unroll 16
    for (int k = ks * 256; k < ks * 256 + 256; k++) {
      float wv = wp[(size_t)k * 3072];
      a0 += sc[k] * wv; a1 += sc[1024 + k] * wv; a2 += sc[2048 + k] * wv; a3 += sc[3072 + k] * wv; a4 += sc[4096 + k] * wv;
    }
    red[(ks * 5 + 0) * 64 + col] = a0; red[(ks * 5 + 1) * 64 + col] = a1; red[(ks * 5 + 2) * 64 + col] = a2;
    red[(ks * 5 + 3) * 64 + col] = a3; red[(ks * 5 + 4) * 64 + col] = a4;
    __syncthreads();
    for (int i = tid; i < 5 * 64; i += 256) {
      int v = i >> 6, cc = i & 63;
      float s = red[(0 * 5 + v) * 64 + cc] + red[(1 * 5 + v) * 64 + cc] + red[(2 * 5 + v) * 64 + cc] + red[(3 * 5 + v) * 64 + cc];
      p.mod[(l * 5 + v) * 3072 + j0 + cc] = s + p.b_mod[l * 3072 + j0 + cc];
    }
    __syncthreads();
  }
  const int gtid = obid() * 256 + tid, gsz = gridDim.x * 256;
  for (int i = gtid; i < 2 * 4 * 128 * 128; i += gsz) p.wsp[i] = f2bf(p.w_sp[i]);
  for (int i = gtid; i < 128 * 128; i += gsz) {
    int m = i >> 7, k = i & 127;
    int wmm = m >> 6, rip = (m >> 5) & 1, k1 = wmm * 32 + (m & 31);
    int ri = k >> 6, t1 = k & 63;
    float s, c;
    sincospif((float)((k1 * t1) & 63) / 32.f, &s, &c);
    float v = rip == 0 ? (ri == 0 ? c : s) : (ri == 0 ? -s : c);
    p.m1[i] = f2bf(v);
  }
  for (int i = gtid; i < 128 * 256; i += gsz) {
    int k2 = i >> 8, k = i & 255;
    int ri = k >> 7, t2 = k & 127;
    float s, c;
    sincospif((float)((t2 * k2) & 127) / 64.f, &s, &c);
    p.m2[i] = f2bf(ri == 0 ? c : s);
  }
  for (int i = gtid; i < 256 * 512; i += gsz) {
    int tp = i >> 9, k = i & 511;
    int ri = k >> 8, t = k & 255;
    float s, c;
    sincospif((float)((t * tp) & 255) / 128.f, &s, &c);
    p.mctx[i] = f2bf(ri == 0 ? c : s);
  }
  for (int i = gtid; i < 128 * 64; i += gsz) {
    int t2 = i >> 6, k1 = i & 63;
    float s, c;
    sincospif((float)(t2 * k1) / 4096.f, &s, &c);
    p.tw[2 * i] = c;
    p.tw[2 * i + 1] = s;
  }
  __syncthreads();
  if (tid < 128) {
    float s, co;
    sincospif((float)tid / 64.f, &s, &co);
    fs[tid] = co;
    fs[128 + tid] = -s;
  }
  __syncthreads();
  for (int i = gtid; i < 2 * 4 * 128 * 256; i += gsz) {
    int d = i & 127, ri = (i >> 7) & 1, c = (i >> 8) & 127, lg = i >> 15;
    const float* wf = p.w_fno + (size_t)lg * 128 * 128 + d;
    const float* tr = fs + ri * 128;
    float acc = 0.f;
#pragma unroll 8
    for (int cp = 0; cp < 128; cp++) acc += tr[(c * cp) & 127] * wf[cp * 128];
    p.Q[i] = acc * 0.08838834764831845f;
  }
}

DEV void phase0b(const Params& p, unsigned char* smem) {
  const int tid = otid();
  float* wl = (float*)smem;
  for (int it = obid(); it < 256; it += gridDim.x) {
    int l = it >> 7, k0 = (it & 127) * 8;
    const float* wsrc = p.w_in + (size_t)l * D * NIN + (size_t)k0 * NIN + SRC_F;
    {
      float4 wv4[4];
#pragma unroll
      for (int i = 0; i < 4; i++) {
        int idx = tid + 256 * i;
        int kk = idx >> 7, f4 = (idx & 127) * 4;
        wv4[i] = *(const float4*)(wsrc + (size_t)kk * NIN + f4);
      }
#pragma unroll
      for (int i = 0; i < 4; i++) {
        int idx = tid + 256 * i;
        int kk = idx >> 7, f4 = (idx & 127) * 4;
        wl[(f4 + 0) * 8 + kk] = wv4[i].x; wl[(f4 + 1) * 8 + kk] = wv4[i].y; wl[(f4 + 2) * 8 + kk] = wv4[i].z; wl[(f4 + 3) * 8 + kk] = wv4[i].w;
      }
    }
    __syncthreads();
    for (int jj = 0; jj < 4; jj++) {
      int np = tid + 256 * jj;
      int d = np & 127, g = (np >> 7) & 3, ri = np >> 9;
      float acc[8];
#pragma unroll
      for (int kk = 0; kk < 8; kk++) acc[kk] = 0.f;
      const float* qp = p.Q + ((size_t)(l * 4 + g) * 128) * 256 + ri * 128 + d;
      const float* wp = wl + g * 128 * 8;
#pragma unroll 16
      for (int c = 0; c < 128; c++) {
        float qv = qp[c * 256];
        float4 w0 = *(const float4*)(wp + c * 8), w1 = *(const float4*)(wp + c * 8 + 4);
        acc[0] += w0.x * qv; acc[1] += w0.y * qv; acc[2] += w0.z * qv; acc[3] += w0.w * qv;
        acc[4] += w1.x * qv; acc[5] += w1.y * qv; acc[6] += w1.z * qv; acc[7] += w1.w * qv;
      }
      int n = (ri ? CHI : CHR) + g * 128 + d;
      uint4 o = make_uint4(pack2(acc[0], acc[1]), pack2(acc[2], acc[3]), pack2(acc[4], acc[5]), pack2(acc[6], acc[7]));
      *(uint4*)(p.wt_in + ((size_t)l * NPW + n) * D + k0) = o;
    }
    __syncthreads();
  }
}

DEV void phase1(const Params& p, int l) {
  const int lane = otid() & 63, w = otid() >> 6;
  for (int r = obid() * 4 + w; r < ROWS; r += gridDim.x * 4) {
    int b = r / TB, j = r % TB;
    const float* xin;
    int mv;
    if (j < 256) {
      xin = (l == 0 ? p.ctx : p.xc1) + ((size_t)b * 256 + j) * D;
      mv = 4;
    } else {
      xin = (l == 0 ? p.x : p.out) + ((size_t)b * 8192 + (j - 256)) * D;
      mv = b;
    }
    const float* md = p.mod + (size_t)(l * 5 + mv) * 3072;
    float4 v[4];
    float ss = 0.f;
#pragma unroll
    for (int i = 0; i < 4; i++) {
      v[i] = nt_load4(xin + lane * 4 + 256 * i);
      ss += v[i].x * v[i].x + v[i].y * v[i].y + v[i].z * v[i].z + v[i].w * v[i].w;
    }
#pragma unroll
    for (int off = 32; off; off >>= 1) ss += __shfl_xor(ss, off);
    float rstd = rsqrtf(ss * (1.f / 1024.f) + EPS);
#pragma unroll
    for (int i = 0; i < 4; i++) {
      int col = lane * 4 + 256 * i;
      float4 g = *(const float4*)(p.g_pre + l * D + col);
      float4 sh = *(const float4*)(md + col);
      float4 sc = *(const float4*)(md + 1024 + col);
      float o0 = v[i].x * rstd * g.x * (1.f + sc.x) + sh.x;
      float o1 = v[i].y * rstd * g.y * (1.f + sc.y) + sh.y;
      float o2 = v[i].z * rstd * g.z * (1.f + sc.z) + sh.z;
      float o3 = v[i].w * rstd * g.w * (1.f + sc.w) + sh.w;
      *(uint2*)(p.hN + (size_t)r * D + col) = make_uint2(pack2(o0, o1), pack2(o2, o3));
    }
  }
}

DEV void phase2(const Params& p, int l, int hf, unsigned char* smem) {
  bf* sA = (bf*)smem;
  bf* sB = (bf*)(smem + 40960);
  const int bid = obid();
  const int nxb = gridDim.x >> 3, xcd = bid & 7, lb = bid >> 3;
  const int per = (66 * 57 + 7) / 8;
  const int tend = min((xcd + 1) * per, 66 * 57);
  for (int t = xcd * per + lb; t < tend; t += nxb) {
    int ms, rem, rows_in;
    if (t < 8 * 8 * 57) { ms = t / 456; rem = t - ms * 456; rows_in = 8; }
    else { ms = 8; rem = t - 8 * 456; rows_in = 2; }
    int ns = rem / (rows_in * 8);
    if (ns > 7) ns = 7;
    int r2 = rem - ns * rows_in * 8;
    int mt = ms * 8 + (r2 % rows_in), nt = ns * 8 + (r2 / rows_in);
    const bf* A = p.hN + ((size_t)hf * HROWS + mt * 256) * D;
    const bf* B = p.wt_in + ((size_t)l * NPW + nt * 128) * D;
    f32x16 acc[4][2];
    auto gA = [&](int kt, int r, int ko) -> uint4 { return *(const uint4*)(A + (unsigned)(r * D + kt * 32 + ko)); };
    auto gB = [&](int kt, int r, int ko) -> uint4 { return *(const uint4*)(B + (unsigned)(r * D + kt * 32 + ko)); };
    block_gemm<256, 128, 32, false, false, true>(acc, gA, gB, 32, sA, sB);
    if (nt == CG / 128) {
      acc_foreach<256, 128>(acc, [&](int row, int col, float v) {
        if (col < 32) p.gates[(unsigned)((mt * 256 + row) * 32 + col)] = v + p.b_gate[l * 32 + col];
      });
    }
    store_tile_bf16<256>(acc, (bf*)smem, [&](int row) -> bf* { return p.P + pidx(mt * 256 + row, nt * 128); }, min(128, NP - nt * 128));
  }
}

DEV void gate_prep(const float* __restrict__ gch, int h, float* vec, bool want_w) {
  const int tid = otid(), lane = tid & 63, w = tid >> 6;
  if (w < 2) {
    const int d = w;
    int p0 = 2 * lane, p1 = p0 + 1;
    int i0 = d ? 127 - p0 : p0, i1 = d ? 127 - p1 : p1;
    float ig0 = gch[i0 * 32 + (2 * d) * 8 + h], ig1 = gch[i1 * 32 + (2 * d) * 8 + h];
    float lf0 = logsigmoid(gch[i0 * 32 + (2 * d + 1) * 8 + h]), lf1 = logsigmoid(gch[i1 * 32 + (2 * d + 1) * 8 + h]);
    float incl = lf0 + lf1;
#pragma unroll
    for (int off = 1; off < 64; off <<= 1) {
      float t = __shfl_up(incl, off);
      if (lane >= off) incl += t;
    }
    float b1 = incl, b0 = incl - lf1;
    float a0 = ig0 - b0, a1 = ig1 - b1;
    float mincl = fmaxf(a0, a1);
#pragma unroll
    for (int off = 1; off < 64; off <<= 1) {
      float t = __shfl_up(mincl, off);
      if (lane >= off) mincl = fmaxf(mincl, t);
    }
    float prev = __shfl_up(mincl, 1);
    float pm0 = lane ? fmaxf(prev, a0) : a0, pm1 = mincl;
    float tot = __shfl(b1, 63);
    vec[d * 128 + i0] = ig0;
    vec[d * 128 + i1] = ig1;
    vec[256 + d * 128 + i0] = b0;
    vec[256 + d * 128 + i1] = b1;
    if (want_w) {
      float wl0 = tot - b0 + ig0, wl1 = tot - b1 + ig1;
      float mx = fmaxf(wl0, wl1);
#pragma unroll
      for (int off = 32; off; off >>= 1) mx = fmaxf(mx, __shfl_xor(mx, off));
      vec[512 + d * 128 + i0] = __expf(wl0 - mx);
      vec[512 + d * 128 + i1] = __expf(wl1 - mx);
      if (lane == 0) {
        vec[1152 + d * 2] = tot;
        vec[1152 + d * 2 + 1] = mx;
      }
    } else {
      vec[512 + d * 128 + i0] = pm0;
      vec[512 + d * 128 + i1] = pm1;
      if (lane == 0) vec[1152 + d * 2] = tot;
    }
  }
  __syncthreads();
}

DEV void mlstm_dc_item(const Params& p, int it, unsigned char* smem) {
  bf* sA = (bf*)smem;
  bf* sB = (bf*)(smem + OFF_SB);
  float* vec = (float*)(smem + OFF_VEC);
  const int tid = otid();
  int j = it % 66, h = (it / 66) & 7, bl = it / 528;
  size_t base = (size_t)bl * TB + j * 128;
  gate_prep(p.gates + base * 32, h, vec, true);
  const bf* Pb = p.P;
  const int rb = (int)base;
  for (int d = 0; d < 2; d++) {
    int sid = (bl * 8 + h) * 2 + d;
    bf* slot = p.states + ((size_t)sid * 66 + j) * 8192;
    float* nslot = p.nbuf + ((size_t)sid * 66 + j) * 64;
    const float* wv = vec + 512 + d * 128;
    f32x16 acc[1][2];
    auto gA = [&](int kt, int to, int c) -> uint4 {
      int tok = kt * 64 + to;
      return *(const uint4*)(Pb + pidx(rb + tok, CK + h * 64 + c));
    };
    auto gB = [&](int kt, int to, int c) -> uint4 {
      int tok = kt * 64 + to;
      return scale8(*(const uint4*)(Pb + pidx(rb + tok, CV + h * 128 + c)), wv[tok]);
    };
    block_gemm<64, 128, 64, true, true, true>(acc, gA, gB, 2, sA, sB);
    store_tile_bf16<64>(acc, (bf*)smem, [&](int row) -> bf* { return slot + row * 128; }, 128);
    {
      float* red = vec + 768;
      int dk = tid & 63, part = tid >> 6;
      float sacc = 0.f;
#pragma unroll 8
      for (int t = part * 32; t < part * 32 + 32; t++) sacc += wv[t] * bf2f(Pb[pidx(rb + t, CK + h * 64 + dk)]);
      red[part * 64 + dk] = sacc;
      __syncthreads();
      if (tid < 64) nslot[tid] = red[tid] + red[64 + tid] + red[128 + tid] + red[192 + tid];
    }
    if (tid == 0) {
      p.scal[(sid * 66 + j) * 2] = vec[1152 + d * 2];
      p.scal[(sid * 66 + j) * 2 + 1] = vec[1152 + d * 2 + 1];
    }
  }
  __syncthreads();
}

DEV void sgu_item(const Params& p, int l, int it, unsigned char* smem) {
  bf* sA = (bf*)smem;
  bf* sB = (bf*)(smem + OFF_SB);
  float* rstd = (float*)(smem + OFF_VEC);
  const int tid = otid();
  int g = it & 3, j = (it >> 2) % 66, bl = it / 264;
  size_t base = (size_t)bl * TB + j * 128;
  bf* Pb = p.P;
  const int rb = (int)base;
  {
    int t = tid >> 1, hh = tid & 1;
    float ss = 0.f;
    for (int i = 0; i < 32; i++) {
      uint4 u = *(const uint4*)(Pb + pidx(rb + t, CVS + hh * 256 + i * 8));
      float a;
      a = lo2f(u.x); ss += a * a; a = hi2f(u.x); ss += a * a;
      a = lo2f(u.y); ss += a * a; a = hi2f(u.y); ss += a * a;
      a = lo2f(u.z); ss += a * a; a = hi2f(u.z); ss += a * a;
      a = lo2f(u.w); ss += a * a; a = hi2f(u.w); ss += a * a;
    }
    ss += __shfl_xor(ss, 1);
    if (hh == 0) rstd[t] = rsqrtf(ss * (1.f / 512.f) + EPS);
  }
  __syncthreads();
  const bf* W = p.wsp + (size_t)(l * 4 + g) * 128 * 128;
  const float* gs = p.g_sgu + l * 512 + g * 128;
  f32x16 acc[2][2];
  auto gA = [&](int kt, int r, int ko) -> uint4 { return *(const uint4*)(W + r * 128 + kt * 64 + ko); };
  auto gB = [&](int kt, int to, int c) -> uint4 {
    int tok = kt * 64 + to;
    return scale8(*(const uint4*)(Pb + pidx(rb + tok, CVS + g * 128 + c)), rstd[tok]);
  };
  block_gemm<128, 128, 64, false, true, true>(acc, gA, gB, 2, sA, sB);
  const float* bs = p.b_sp + (size_t)(l * 4 + g) * 128;
  float* Hs = (float*)smem;
  acc_foreach<128, 128>(acc, [&](int t, int c, float v) { Hs[t * 132 + c] = v; });
  __syncthreads();
  {
    const int t = tid >> 1, hh = tid & 1;
    const float* hrow = Hs + t * 132 + hh * 64;
    const float* gp = gs + hh * 64;
    const float bt = bs[t];
#pragma unroll 2
    for (int i = 0; i < 8; i++) {
      bf* up = Pb + pidx(rb + t, CU + g * 128 + hh * 64 + i * 8);
      uint4 uu = *(const uint4*)up;
      uint4 uz = *(const uint4*)(Pb + pidx(rb + t, CZB + g * 128 + hh * 64 + i * 8));
      float4 h0 = *(const float4*)(hrow + i * 8), h1 = *(const float4*)(hrow + i * 8 + 4);
      float4 g0 = *(const float4*)(gp + i * 8), g1 = *(const float4*)(gp + i * 8 + 4);
      float y0 = lo2f(uu.x) * (h0.x * g0.x + bt) * silu(lo2f(uz.x));
      float y1 = hi2f(uu.x) * (h0.y * g0.y + bt) * silu(hi2f(uz.x));
      float y2 = lo2f(uu.y) * (h0.z * g0.z + bt) * silu(lo2f(uz.y));
      float y3 = hi2f(uu.y) * (h0.w * g0.w + bt) * silu(hi2f(uz.y));
      float y4 = lo2f(uu.z) * (h1.x * g1.x + bt) * silu(lo2f(uz.z));
      float y5 = hi2f(uu.z) * (h1.y * g1.y + bt) * silu(hi2f(uz.z));
      float y6 = lo2f(uu.w) * (h1.z * g1.z + bt) * silu(lo2f(uz.w));
      float y7 = hi2f(uu.w) * (h1.w * g1.w + bt) * silu(hi2f(uz.w));
      *(uint4*)up = make_uint4(pack2(y0, y1), pack2(y2, y3), pack2(y4, y5), pack2(y6, y7));
    }
  }
  __syncthreads();
}

DEV void fourA_item(const Params& p, int it, unsigned char* smem) {
  bf* sA = (bf*)smem;
  bf* sB = (bf*)(smem + OFF_SB);
  int cht = it & 3, t2 = (it >> 2) & 127, bl = it >> 9;
  const bf* Pb = p.P;
  const int rb = bl * TB + 256 + t2;
  f32x16 acc[2][2];
  auto gA = [&](int kt, int r, int ko) -> uint4 { return *(const uint4*)(p.m1 + r * 128 + kt * 64 + ko); };
  auto gB = [&](int kt, int to, int c) -> uint4 {
    int ri = kt, t1 = to;
    return *(const uint4*)(Pb + pidx(rb + t1 * 128, (ri ? CHI : CHR) + cht * 128 + c));
  };
  block_gemm<128, 128, 64, false, true, true>(acc, gA, gB, 2, sA, sB);
  float* Ha = (float*)smem;
  acc_foreach<128, 128>(acc, [&](int m, int c, float v) { Ha[m * 132 + c] = v; });
  __syncthreads();
  {
    const int tid = otid();
    const int k1 = tid >> 2, cq = (tid & 3) * 32;
    const float* ar = Ha + ((k1 >> 5) * 64 + (k1 & 31)) * 132 + cq;
    const float* ai = ar + 32 * 132;
    const float c = p.tw[(t2 * 64 + k1) * 2], sn = p.tw[(t2 * 64 + k1) * 2 + 1];
    bf* ore = p.abuf + ((((((size_t)bl * 64 + k1) * 4 + cht) * 2) * 128 + t2) * 128) + cq;
    bf* oim = ore + (size_t)128 * 128;
#pragma unroll
    for (int i = 0; i < 4; i++) {
      float4 r0 = *(const float4*)(ar + i * 8), r1 = *(const float4*)(ar + i * 8 + 4);
      float4 i0 = *(const float4*)(ai + i * 8), i1 = *(const float4*)(ai + i * 8 + 4);
      *(uint4*)(ore + i * 8) = make_uint4(pack2(r0.x * c + i0.x * sn, r0.y * c + i0.y * sn), pack2(r0.z * c + i0.z * sn, r0.w * c + i0.w * sn),
                                          pack2(r1.x * c + i1.x * sn, r1.y * c + i1.y * sn), pack2(r1.z * c + i1.z * sn, r1.w * c + i1.w * sn));
      *(uint4*)(oim + i * 8) = make_uint4(pack2(i0.x * c - r0.x * sn, i0.y * c - r0.y * sn), pack2(i0.z * c - r0.z * sn, i0.w * c - r0.w * sn),
                                          pack2(i1.x * c - r1.x * sn, i1.y * c - r1.y * sn), pack2(i1.z * c - r1.z * sn, i1.w * c - r1.w * sn));
    }
  }
  __syncthreads();
}

DEV void fourCtx_item(const Params& p, int l, int it, unsigned char* smem) {
  bf* sA = (bf*)smem;
  bf* sB = (bf*)(smem + OFF_SB);
  int mt = it & 1, g = (it >> 1) & 3, bl = it >> 3;
  const bf* Pb = p.P;
  const int rb = bl * TB;
  f32x16 acc[2][2];
  auto gA = [&](int kt, int r, int ko) -> uint4 { return *(const uint4*)(p.mctx + (mt * 128 + r) * 512 + kt * 64 + ko); };
  auto gB = [&](int kt, int to, int c) -> uint4 {
    int ri = kt >> 2, t = (kt & 3) * 64 + to;
    return *(const uint4*)(Pb + pidx(rb + t, (ri ? CHI : CHR) + g * 128 + c));
  };
  block_gemm<128, 128, 64, false, true, true>(acc, gA, gB, 8, sA, sB);
  float* Hs = (float*)smem;
  acc_foreach<128, 128>(acc, [&](int tl, int d, float v) { Hs[tl * 132 + d] = v; });
  __syncthreads();
  {
    const int tid = otid();
    const int tl = tid >> 1, hh = tid & 1;
    const int tp = mt * 128 + tl;
    const float* hrow = Hs + tl * 132 + hh * 64;
    const float* bp = p.b_fno + l * 512 + g * 128 + hh * 64;
    bf* op = p.cbuf + ((size_t)bl * 256 + tp) * 512 + g * 128 + hh * 64;
#pragma unroll 2
    for (int i = 0; i < 8; i++) {
      uint4 uz = *(const uint4*)(Pb + pidx(rb + tp, CZC + g * 128 + hh * 64 + i * 8));
      float4 h0 = *(const float4*)(hrow + i * 8), h1 = *(const float4*)(hrow + i * 8 + 4);
      float4 b0 = *(const float4*)(bp + i * 8), b1 = *(const float4*)(bp + i * 8 + 4);
      float y0 = (h0.x * 0.0625f + b0.x) * silu(lo2f(uz.x)), y1 = (h0.y * 0.0625f + b0.y) * silu(hi2f(uz.x));
      float y2 = (h0.z * 0.0625f + b0.z) * silu(lo2f(uz.y)), y3 = (h0.w * 0.0625f + b0.w) * silu(hi2f(uz.y));
      float y4 = (h1.x * 0.0625f + b1.x) * silu(lo2f(uz.z)), y5 = (h1.y * 0.0625f + b1.y) * silu(hi2f(uz.z));
      float y6 = (h1.z * 0.0625f + b1.z) * silu(lo2f(uz.w)), y7 = (h1.w * 0.0625f + b1.w) * silu(hi2f(uz.w));
      *(uint4*)(op + i * 8) = make_uint4(pack2(y0, y1), pack2(y2, y3), pack2(y4, y5), pack2(y6, y7));
    }
  }
  __syncthreads();
}

DEV void phase3(const Params& p, int l, unsigned char* smem) {
  const int n0 = 1056, n1 = n0 + 528, n2 = n1 + 1024, n3 = n2 + 16;
  for (int it = obid(); it < n3; it += gridDim.x) {
    if (it < n0) mlstm_dc_item(p, it, smem);
    else if (it < n1) sgu_item(p, l, it - n0, smem);
    else if (it < n2) fourA_item(p, it - n1, smem);
    else fourCtx_item(p, l, it - n2, smem);
  }
}

DEV int chunk_at(int d, int pp) { return d ? (pp == 0 ? 1 : (pp == 1 ? 0 : 67 - pp)) : pp; }
DEV void scan_item(const Params& p, int it, unsigned char* smem) {
  float* tab = (float*)(smem + OFF_VEC);
  const int tid = otid();
  int eb = it & 15, sid = it >> 4;
  int d = sid & 1;
  if (tid < 66) {
    int j = chunk_at(d, tid);
    tab[256 + tid] = p.scal[(sid * 66 + j) * 2];
    tab[384 + tid] = p.scal[(sid * 66 + j) * 2 + 1];
  }
  __syncthreads();
  if (tid == 0) {
    float m = 0.f;
    for (int pp = 0; pp < 66; pp++) {
      float bl_ = tab[256 + pp], ml = tab[384 + pp];
      float mn = fmaxf(bl_ + m, ml);
      tab[pp] = __expf(bl_ + m - mn);
      tab[128 + pp] = __expf(ml - mn);
      if (eb == 0) p.mstart[sid * 66 + chunk_at(d, pp)] = m;
      m = mn;
    }
  }
  __syncthreads();
  {
    float v0 = 0.f, v1 = 0.f;
    unsigned* basep = (unsigned*)(p.states + (size_t)sid * 66 * 8192) + eb * 256 + tid;
#pragma unroll 1
    for (int pb = 0; pb < 66; pb += 33) {
      unsigned dv[33];
#pragma unroll
      for (int u = 0; u < 33; u++) dv[u] = basep[(size_t)chunk_at(d, pb + u) * 4096];
#pragma unroll
      for (int u = 0; u < 33; u++) {
        basep[(size_t)chunk_at(d, pb + u) * 4096] = pack2(v0, v1);
        float de = tab[pb + u], sc = tab[128 + pb + u];
        v0 = de * v0 + sc * lo2f(dv[u]);
        v1 = de * v1 + sc * hi2f(dv[u]);
      }
    }
  }
  if (eb == 0 && tid < 64) {
    float val = 0.f;
    float* basep = p.nbuf + (size_t)sid * 66 * 64 + tid;
#pragma unroll 1
    for (int pb = 0; pb < 66; pb += 33) {
      float dv[33];
#pragma unroll
      for (int u = 0; u < 33; u++) dv[u] = basep[chunk_at(d, pb + u) * 64];
#pragma unroll
      for (int u = 0; u < 33; u++) {
        basep[chunk_at(d, pb + u) * 64] = val;
        val = tab[pb + u] * val + tab[128 + pb + u] * dv[u];
      }
    }
  }
  __syncthreads();
}

DEV void fourC_item(const Params& p, int l, int it, unsigned char* smem) {
  bf* sA = (bf*)smem;
  bf* sB = (bf*)(smem + OFF_SB);
  int g = it & 3, k1 = (it >> 2) & 63, bl = it >> 8;
  const bf* Ab = p.abuf + ((((size_t)bl * 64 + k1) * 4 + g) * 2) * 128 * 128;
  f32x16 acc[2][2];
  auto gA = [&](int kt, int r, int ko) -> uint4 { return *(const uint4*)(p.m2 + r * 256 + kt * 64 + ko); };
  auto gB = [&](int kt, int to, int c) -> uint4 {
    int kk = kt * 64 + to;
    return *(const uint4*)(Ab + (unsigned)(kk * 128 + c));
  };
  block_gemm<128, 128, 64, false, true, true>(acc, gA, gB, 4, sA, sB);
  bf* Pb = p.P;
  const int rb = bl * TB + 256;
  float* Hs = (float*)smem;
  acc_foreach<128, 128>(acc, [&](int k2, int d, float v) { Hs[k2 * 132 + d] = v; });
  __syncthreads();
  {
    const int tid = otid();
    const int k2 = tid >> 1, hh = tid & 1;
    const int tp = k1 + 64 * k2;
    const float* hrow = Hs + k2 * 132 + hh * 64;
    const float* bp = p.b_fno + l * 512 + g * 128 + hh * 64;
    const float sc = 0.011048543456039806f;
#pragma unroll 2
    for (int i = 0; i < 8; i++) {
      uint4 uz = *(const uint4*)(Pb + pidx(rb + tp, CZC + g * 128 + hh * 64 + i * 8));
      bf* op = Pb + pidx(rb + tp, CHR + g * 128 + hh * 64 + i * 8);
      float4 h0 = *(const float4*)(hrow + i * 8), h1 = *(const float4*)(hrow + i * 8 + 4);
      float4 b0 = *(const float4*)(bp + i * 8), b1 = *(const float4*)(bp + i * 8 + 4);
      float y0 = (h0.x * sc + b0.x) * silu(lo2f(uz.x)), y1 = (h0.y * sc + b0.y) * silu(hi2f(uz.x));
      float y2 = (h0.z * sc + b0.z) * silu(lo2f(uz.y)), y3 = (h0.w * sc + b0.w) * silu(hi2f(uz.y));
      float y4 = (h1.x * sc + b1.x) * silu(lo2f(uz.z)), y5 = (h1.y * sc + b1.y) * silu(hi2f(uz.z));
      float y6 = (h1.z * sc + b1.z) * silu(lo2f(uz.w)), y7 = (h1.w * sc + b1.w) * silu(hi2f(uz.w));
      *(uint4*)op = make_uint4(pack2(y0, y1), pack2(y2, y3), pack2(y4, y5), pack2(y6, y7));
    }
  }
  __syncthreads();
}

DEV void phase4(const Params& p, int l, unsigned char* smem) {
  const int n0 = 512, n1 = n0 + 32 * 16;
  for (int it = obid(); it < n1; it += gridDim.x) {
    if (it < n0) fourC_item(p, l, it, smem);
    else scan_item(p, it - n0, smem);
  }
  for (int i = obid() * 256 + otid(); i < 2 * 256 * 512; i += gridDim.x * 256) {
    int c = i & 511, t = (i >> 9) & 255, bl = i >> 17;
    p.P[pidx(bl * TB + t, CHR + c)] = p.cbuf[i];
  }
}

DEV void mlstm_out_item(const Params& p, int l, int it, unsigned char* smem) {
  bf* sA = (bf*)smem;
  bf* sB = (bf*)(smem + OFF_SB32);
  bf* Sl = (bf*)(smem + OFF_SL);
  float* vec = (float*)(smem + OFF_VEC);
  float* mrow = vec + 768;
  float* winter = vec + 896;
  float* dinv = vec + 1024;
  float* nst = vec + 1160;
  const int tid = otid(), lane = tid & 63, w = tid >> 6, wm = w >> 1, wn = w & 1;
  int j, h, bl;
  if (l == 0) { j = it % 66; h = (it / 66) & 7; bl = it / 528; }
  else { j = 2 + (it & 63); h = (it >> 6) & 7; bl = it >> 9; }
  size_t base = (size_t)bl * TB + j * 128;
  gate_prep(p.gates + base * 32, h, vec, false);
  bf* Pb = p.P;
  const int rb = (int)base;
  f32x16 acch[2][2];
  for (int d = 0; d < 2; d++) {
    int sid = (bl * 8 + h) * 2 + d;
    const bf* slot = p.states + ((size_t)sid * 66 + j) * 8192;
    const float* nslot = p.nbuf + ((size_t)sid * 66 + j) * 64;
    const float* igv = vec + d * 128;
    const float* bv = vec + 256 + d * 128;
    const float* pmv = vec + 512 + d * 128;
    float ms = p.mstart[sid * 66 + j];
    if (tid < 128) {
      float inter = bv[tid] + ms;
      float mr = fmaxf(inter, bv[tid] + pmv[tid]);
      mrow[tid] = mr;
      winter[tid] = __expf(inter - mr);
    } else if (tid < 192) {
      nst[tid - 128] = nslot[tid - 128];
    }
    __syncthreads();
    {
      f32x16 acc[2][2];
      auto gA = [&](int kt, int r, int ko) -> uint4 { return *(const uint4*)(Pb + pidx(rb + r, CQ + h * 64 + ko)); };
      auto gB = [&](int kt, int r, int ko) -> uint4 { return *(const uint4*)(Pb + pidx(rb + r, CK + h * 64 + ko)); };
      block_gemm<128, 128, 64, false, false>(acc, gA, gB, 1, sA, sB);
      acc_foreach<128, 128>(acc, [&](int t, int s, float v) { Sl[t * 136 + s] = f2bf(v); });
    }
    __syncthreads();
#pragma unroll 1
    for (int i = 0; i < 8; i++) {
      int idx = tid + 256 * i;
      int t = idx >> 4, s0 = (idx & 15) * 8;
      uint4 u = *(const uint4*)(Sl + t * 136 + s0);
      float rowc = bv[t] - mrow[t];
      float4 b0 = *(const float4*)(bv + s0), b1 = *(const float4*)(bv + s0 + 4);
      float4 g0 = *(const float4*)(igv + s0), g1 = *(const float4*)(igv + s0 + 4);
      float e[8];
      e[0] = lo2f(u.x) * __expf(rowc - b0.x + g0.x); e[1] = hi2f(u.x) * __expf(rowc - b0.y + g0.y);
      e[2] = lo2f(u.y) * __expf(rowc - b0.z + g0.z); e[3] = hi2f(u.y) * __expf(rowc - b0.w + g0.w);
      e[4] = lo2f(u.z) * __expf(rowc - b1.x + g1.x); e[5] = hi2f(u.z) * __expf(rowc - b1.y + g1.y);
      e[6] = lo2f(u.w) * __expf(rowc - b1.z + g1.z); e[7] = hi2f(u.w) * __expf(rowc - b1.w + g1.w);
#pragma unroll
      for (int q = 0; q < 8; q++) {
        int sq = s0 + q;
        bool ok = d ? (sq >= t) : (sq <= t);
        e[q] = ok ? 0.125f * e[q] : 0.f;
      }
      *(uint4*)(Sl + t * 136 + s0) = make_uint4(pack2(e[0], e[1]), pack2(e[2], e[3]), pack2(e[4], e[5]), pack2(e[6], e[7]));
    }
    __syncthreads();
    {
      int t = tid >> 1, hh = tid & 1;
      float rs = 0.f, qn = 0.f;
#pragma unroll
      for (int i = 0; i < 8; i++) {
        uint4 u = *(const uint4*)(Sl + t * 136 + hh * 64 + i * 8);
        rs += lo2f(u.x) + hi2f(u.x) + lo2f(u.y) + hi2f(u.y) + lo2f(u.z) + hi2f(u.z) + lo2f(u.w) + hi2f(u.w);
      }
      const bf* qp = Pb + pidx(rb + t, CQ + h * 64 + hh * 32);
      const float* np_ = nst + hh * 32;
#pragma unroll
      for (int i = 0; i < 4; i++) {
        uint4 u = *(const uint4*)(qp + i * 8);
        qn += lo2f(u.x) * np_[i * 8 + 0] + hi2f(u.x) * np_[i * 8 + 1] + lo2f(u.y) * np_[i * 8 + 2] + hi2f(u.y) * np_[i * 8 + 3] +
              lo2f(u.z) * np_[i * 8 + 4] + hi2f(u.z) * np_[i * 8 + 5] + lo2f(u.w) * np_[i * 8 + 6] + hi2f(u.w) * np_[i * 8 + 7];
      }
      rs += __shfl_xor(rs, 1);
      qn += __shfl_xor(qn, 1);
      if (hh == 0) {
        float den = rs + winter[t] * 0.125f * qn;
        dinv[t] = 1.f / fmaxf(fabsf(den), __expf(-mrow[t]));
      }
    }
    __syncthreads();
    {
      auto gA = [&](int kt, int r, int ko) -> uint4 {
        if (kt < 4) return scale8(*(const uint4*)(Sl + r * 136 + kt * 32 + ko), dinv[r]);
        uint4 q = *(const uint4*)(Pb + pidx(rb + r, CQ + h * 64 + (kt - 4) * 32 + ko));
        return scale8(q, winter[r] * 0.125f * dinv[r]);
      };
      auto gB = [&](int kt, int to, int c) -> uint4 {
        if (kt < 4) return *(const uint4*)(Pb + pidx(rb + kt * 32 + to, CV + h * 128 + c));
        return *(const uint4*)(slot + ((kt - 4) * 32 + to) * 128 + c);
      };
      block_gemm<128, 128, 32, false, true, true>(acch, gA, gB, 6, sA, sB, d == 0);
    }
    __syncthreads();
  }
  float* Hs = (float*)smem;
  acc_foreach<128, 128>(acch, [&](int t, int c, float v) { Hs[t * 132 + c] = v; });
  __syncthreads();
  {
    const int t = tid >> 1, hh = tid & 1;
    const float* hrow = Hs + t * 132 + hh * 64;
    float ss = 0.f;
#pragma unroll 4
    for (int i = 0; i < 16; i++) {
      float4 v = *(const float4*)(hrow + i * 4);
      ss += v.x * v.x + v.y * v.y + v.z * v.z + v.w * v.w;
    }
    ss += __shfl_xor(ss, 1);
    const float rstd = rsqrtf(ss * (1.f / 128.f) + EPS);
    const float* gh = p.g_hnorm + l * D + h * 128 + hh * 64;
#pragma unroll 2
    for (int i = 0; i < 8; i++) {
      bf* op = Pb + pidx(rb + t, CO + h * 128 + hh * 64 + i * 8);
      uint4 uo = *(const uint4*)op;
      uint4 uz = *(const uint4*)(Pb + pidx(rb + t, CZA + h * 128 + hh * 64 + i * 8));
      float4 h0 = *(const float4*)(hrow + i * 8), h1 = *(const float4*)(hrow + i * 8 + 4);
      float4 g0 = *(const float4*)(gh + i * 8), g1 = *(const float4*)(gh + i * 8 + 4);
      float y0 = h0.x * rstd * g0.x * sigm(lo2f(uo.x)) * silu(lo2f(uz.x));
      float y1 = h0.y * rstd * g0.y * sigm(hi2f(uo.x)) * silu(hi2f(uz.x));
      float y2 = h0.z * rstd * g0.z * sigm(lo2f(uo.y)) * silu(lo2f(uz.y));
      float y3 = h0.w * rstd * g0.w * sigm(hi2f(uo.y)) * silu(hi2f(uz.y));
      float y4 = h1.x * rstd * g1.x * sigm(lo2f(uo.z)) * silu(lo2f(uz.z));
      float y5 = h1.y * rstd * g1.y * sigm(hi2f(uo.z)) * silu(hi2f(uz.z));
      float y6 = h1.z * rstd * g1.z * sigm(lo2f(uo.w)) * silu(lo2f(uz.w));
      float y7 = h1.w * rstd * g1.w * sigm(hi2f(uo.w)) * silu(hi2f(uz.w));
      *(uint4*)op = make_uint4(pack2(y0, y1), pack2(y2, y3), pack2(y4, y5), pack2(y6, y7));
    }
  }
  __syncthreads();
}

DEV void phase6(const Params& p, int l, unsigned char* smem) {
  bf* sA = (bf*)smem;
  bf* sB = (bf*)(smem + OFF_SB);
  const int bid = obid();
  const int nxb = gridDim.x >> 3, xcd = bid & 7, lb = bid >> 3;
  if (l == 1) {
    bf* sA2 = (bf*)smem;
    bf* sB2 = (bf*)(smem + 40960);
    for (int t = xcd * 64 + lb; t < (xcd + 1) * 64; t += nxb) {
      int m256 = (t >> 6) * 8 + (t & 7), nt = (t >> 3) & 7;
      int rowbase = (m256 >> 5) * TB + 256 + (m256 & 31) * 256;
      const bf* A = p.P;
      const bf* B = p.wt_out + ((size_t)l * D + nt * 128) * 2048;
      f32x16 acc[4][2];
      auto gA = [&](int kt, int r, int ko) -> uint4 {
        int k = kt * 32;
        int col = (kt < 32 ? CO + k : (kt < 48 ? CU + (k - 1024) : CHR + (k - 1536))) + ko;
        return *(const uint4*)(A + pidx(rowbase + r, col));
      };
      auto gB = [&](int kt, int r, int ko) -> uint4 { return *(const uint4*)(B + (unsigned)(r * 2048 + kt * 32 + ko)); };
      block_gemm<256, 128, 32, false, false, true>(acc, gA, gB, 64, sA2, sB2);
      bf* Yt = p.ybuf + (size_t)rowbase * D + nt * 128;
      store_tile_bf16<256>(acc, (bf*)smem, [&](int row) -> bf* { return Yt + (unsigned)(row * D); }, 128);
    }
    return;
  }
  const int nmt = (l == 0) ? 132 : 128;
  const int per = nmt;
  for (int t = xcd * per + lb; t < (xcd + 1) * per; t += nxb) {
    int mtl, nt;
    if (t < 1024) { mtl = (t >> 6) * 8 + (t & 7); nt = (t >> 3) & 7; }
    else { mtl = 128 + ((t - 1024) & 3); nt = (t - 1024) >> 2; }
    int rowbase = (l == 0) ? mtl * 128 : ((mtl >> 6) * TB + 256 + (mtl & 63) * 128);
    const int mt = rowbase >> 7;
    const bf* A = p.P;
    const bf* B = p.wt_out + ((size_t)l * D + nt * 128) * 2048;
    f32x16 acc[2][2];
    auto gA = [&](int kt, int r, int ko) -> uint4 {
      int k = kt * 64;
      int col = (kt < 16 ? CO + k : (kt < 24 ? CU + (k - 1024) : CHR + (k - 1536))) + ko;
      return *(const uint4*)(A + pidx(rowbase + r, col));
    };
    auto gB = [&](int kt, int r, int ko) -> uint4 { return *(const uint4*)(B + (unsigned)(r * 2048 + kt * 64 + ko)); };
    block_gemm<128, 128, 64, false, false, true>(acc, gA, gB, 32, sA, sB);
    bf* Yt = p.ybuf + (size_t)mt * 128 * D + nt * 128;
    store_tile_bf16<128>(acc, (bf*)smem, [&](int row) -> bf* { return Yt + (unsigned)(row * D); }, 128);
  }
}

DEV void phase7(const Params& p, int l, int hf) {
  const int lane = otid() & 63, w = otid() >> 6;
  for (int rl = obid() * 4 + w; rl < HROWS; rl += gridDim.x * 4) {
    int r = hf * HROWS + rl;
    int b = r / TB, j = r % TB;
    const float* xin;
    float* xo;
    int mv;
    if (j < 256) {
      if (l != 0) continue;
      xin = p.ctx + ((size_t)b * 256 + j) * D;
      xo = p.xc1 + ((size_t)b * 256 + j) * D;
      mv = 4;
    } else {
      xin = (l == 0 ? p.x : p.out) + ((size_t)b * 8192 + (j - 256)) * D;
      xo = p.out + ((size_t)b * 8192 + (j - 256)) * D;
      mv = b;
    }
    const float* gt = p.mod + (size_t)(l * 5 + mv) * 3072 + 2048;
    const bf* yp = p.ybuf + (size_t)rl * D;
    float y[16];
    float ss = 0.f;
#pragma unroll
    for (int i = 0; i < 4; i++) {
      uint2 u = *(const uint2*)(yp + lane * 4 + 256 * i);
      y[i * 4 + 0] = lo2f(u.x); y[i * 4 + 1] = hi2f(u.x); y[i * 4 + 2] = lo2f(u.y); y[i * 4 + 3] = hi2f(u.y);
      ss += y[i * 4] * y[i * 4] + y[i * 4 + 1] * y[i * 4 + 1] + y[i * 4 + 2] * y[i * 4 + 2] + y[i * 4 + 3] * y[i * 4 + 3];
    }
#pragma unroll
    for (int off = 32; off; off >>= 1) ss += __shfl_xor(ss, off);
    float rstd = rsqrtf(ss * (1.f / 1024.f) + EPS);
#pragma unroll
    for (int i = 0; i < 4; i++) {
      int col = lane * 4 + 256 * i;
      float4 xv = nt_load4(xin + col);
      float4 g = *(const float4*)(p.g_post + l * D + col);
      float4 gv = *(const float4*)(gt + col);
      float4 o;
      o.x = xv.x + gv.x * (y[i * 4 + 0] * rstd * g.x);
      o.y = xv.y + gv.y * (y[i * 4 + 1] * rstd * g.y);
      o.z = xv.z + gv.z * (y[i * 4 + 2] * rstd * g.z);
      o.w = xv.w + gv.w * (y[i * 4 + 3] * rstd * g.w);
      nt_store4(xo + col, o);
    }
  }
}


#define XB_TMO      128
#define XB_XCNT(j)  (256  + 64 * (j))
#define XB_XSUB(j)  (1280 + 64 * (j))
#define XB_XGEN(j)  (2304 + 64 * (j))
#define XB_TOP      3328
#define XB_TOPGEN   3392
#define XCD_BAR_WORDS 3456
#define XB_SPIN_CAP (1u << 18)
#define LAS __attribute__((address_space(3)))
DEV unsigned xb_ld(unsigned* p) { return __hip_atomic_load(p, __ATOMIC_RELAXED, __HIP_MEMORY_SCOPE_AGENT); }
DEV unsigned xb_add(unsigned* p, unsigned v) { return __hip_atomic_fetch_add(p, v, __ATOMIC_RELAXED, __HIP_MEMORY_SCOPE_AGENT); }
DEV unsigned xb_xcc_id() { return (unsigned)__builtin_amdgcn_s_getreg((3 << 11) | 20) & 0xFu; }
#define XB_SPIN(cond, bar) do { unsigned _sp = 0; while (cond) { __builtin_amdgcn_s_sleep(1); \
    if ((++_sp & 255u) == 0u) { if (xb_ld(&(bar)[XB_TMO])) break; if (_sp > XB_SPIN_CAP) { atomicAdd(&(bar)[XB_TMO], 1u); break; } } } } while (0)
struct XcdBarrier {
  unsigned* bar;
  unsigned x;
  volatile LAS unsigned* st;
};
DEV XcdBarrier xcd_barrier_post(unsigned* bar, volatile LAS unsigned* st) {
  XcdBarrier b;
  b.bar = bar;
  b.x = xb_xcc_id();
  b.st = st;
  if (threadIdx.x == 0) (void)xb_add(&bar[XB_XCNT(b.x)], 1u);
  return b;
}
DEV void xcd_barrier_complete(unsigned* bar, unsigned x, unsigned& nloc, unsigned& nx) {
  const unsigned G = gridDim.x * gridDim.y * gridDim.z;
  unsigned sum, cnt, mine, sp = 0u;
  for (;;) {
    sum = 0u; cnt = 0u; mine = 0u;
#pragma unroll
    for (unsigned j = 0; j < 16; ++j) {
      const unsigned c = xb_ld(&bar[XB_XCNT(j)]);
      sum += c;
      cnt += (c > 0u) ? 1u : 0u;
      mine = (j == x) ? c : mine;
    }
    if (sum == G) break;
    __builtin_amdgcn_s_sleep(1);
    if ((++sp & 255u) == 0u) {
      if (xb_ld(&bar[XB_TMO])) break;
      if (sp > XB_SPIN_CAP) { atomicAdd(&bar[XB_TMO], 1u); break; }
    }
  }
  nloc = mine > 0u ? mine : 1u;
  nx = cnt > 0u ? cnt : 1u;
}
DEV void xcd_barrier(const XcdBarrier& b) {
  asm volatile("s_waitcnt vmcnt(0)" ::: "memory");
  __syncthreads();
  if (threadIdx.x == 0) {
    unsigned* bar = b.bar;
    __builtin_amdgcn_s_waitcnt(0);
    unsigned nloc = b.st[0], nx = b.st[1];
    if (nloc == 0u) {
      xcd_barrier_complete(bar, b.x, nloc, nx);
      b.st[0] = nloc;
      b.st[1] = nx;
    }
    const unsigned old = xb_add(&bar[XB_XSUB(b.x)], 1u);
    const unsigned gen = old / nloc;
    if (old + 1u == (gen + 1u) * nloc) {
      __builtin_amdgcn_fence(__ATOMIC_RELEASE, "agent");
      asm volatile("s_waitcnt vmcnt(0)" ::: "memory");
      const unsigned og = xb_add(&bar[XB_TOP], 1u);
      const unsigned tg = og / nx;
      if (og + 1u == (tg + 1u) * nx) xb_add(&bar[XB_TOPGEN], 1u);
      else XB_SPIN(xb_ld(&bar[XB_TOPGEN]) == tg, bar);
      __builtin_amdgcn_fence(__ATOMIC_ACQUIRE, "agent");
      xb_add(&bar[XB_XGEN(b.x)], 1u);
      asm volatile("s_waitcnt vmcnt(0)" ::: "memory");
    } else {
      XB_SPIN(xb_ld(&bar[XB_XGEN(b.x)]) == gen, bar);
      __builtin_amdgcn_fence(__ATOMIC_ACQUIRE, "agent");
      asm volatile("s_waitcnt vmcnt(0)" ::: "memory");
    }
  }
  __syncthreads();
}

__global__ void __launch_bounds__(256, 2) mk_forward(Params p) {
  extern __shared__ __attribute__((aligned(16))) unsigned char smem[];
  cg::grid_group grid = cg::this_grid();
  volatile LAS unsigned* xst = (volatile LAS unsigned*)(smem + LDS_BYTES - 16);
  if (threadIdx.x == 0) { xst[0] = 0u; xst[1] = 0u; xst[2] = 0u; xst[3] = 0u; }
  __syncthreads();
  XcdBarrier xb = xcd_barrier_post(p.bar, xst);
  phase0a(p, smem);
  if (p.bar == nullptr) grid.sync();
  xcd_barrier(xb);
  phase0b(p, smem);
  phase1(p, 0);
  xcd_barrier(xb);
  for (int l = 0; l < 2; l++) {
    for (int hf = 0; hf < 2; hf++) {
      if (hf == 0) {
        phase2(p, l, 0, smem);
        xcd_barrier(xb);
      }
      phase3(p, l, smem);
      xcd_barrier(xb);
      phase4(p, l, smem);
      xcd_barrier(xb);
      for (int it = obid(); it < (l == 0 ? 1056 : 1024); it += gridDim.x) mlstm_out_item(p, l, it, smem);
      xcd_barrier(xb);
      phase6(p, l, smem);
      xcd_barrier(xb);
      phase7(p, l, hf);
      if (hf == 0) {
        phase2(p, l, 1, smem);
        xcd_barrier(xb);
      }
    }
    if (l == 0) {
      xcd_barrier(xb);
      phase1(p, 1);
      xcd_barrier(xb);
    }
  }
}

extern "C" void kernel_launch(void* const* d_in, const int* in_sizes, int n_in, void* d_out, int out_size, void* d_ws,
                              size_t ws_size, hipStream_t stream) {
  static int grid_blocks = 0;
  if (grid_blocks == 0) {
    int dev = 0, cus = 0, per_cu = 0;
    hipGetDevice(&dev);
    hipDeviceGetAttribute(&cus, hipDeviceAttributeMultiprocessorCount, dev);
    if (hipFuncSetAttribute((const void*)mk_forward, hipFuncAttributeMaxDynamicSharedMemorySize, LDS_BYTES) != hipSuccess) {
      fprintf(stderr, "hipFuncSetAttribute failed\n");
    }
    if (hipOccupancyMaxActiveBlocksPerMultiprocessor(&per_cu, (const void*)mk_forward, 256, LDS_BYTES) != hipSuccess || per_cu < 1) {
      fprintf(stderr, "occupancy query failed (%d)\n", per_cu);
      per_cu = 1;
    }
    (void)hipGetLastError();
    if (per_cu > 2) per_cu = 2;
    grid_blocks = cus * per_cu;
  }
  Params p{};
  p.x = (const float*)d_in[0]; p.c = (const float*)d_in[1]; p.ctx = (const float*)d_in[2]; p.c_ctx = (const float*)d_in[3];
  p.w_mod = (const float*)d_in[4]; p.b_mod = (const float*)d_in[5]; p.g_pre = (const float*)d_in[6];
  p.g_post = (const float*)d_in[7]; p.w_in = (const float*)d_in[8]; p.b_gate = (const float*)d_in[9];
  p.g_hnorm = (const float*)d_in[10]; p.g_sgu = (const float*)d_in[11]; p.w_sp = (const float*)d_in[12];
  p.b_sp = (const float*)d_in[13]; p.w_fno = (const float*)d_in[14]; p.b_fno = (const float*)d_in[15];
  p.w_out = (const float*)d_in[16];
  p.out = (float*)d_out;
  size_t off = 0;
  unsigned char* ws = (unsigned char*)d_ws;
  auto take = [&](size_t bytes) -> void* {
    void* r = ws + off;
    off += (bytes + 255) & ~(size_t)255;
    return r;
  };
  p.wt_in = (bf*)take((size_t)2 * NPW * D * 2);
  p.wt_out = (bf*)take((size_t)2 * D * 2048 * 2);
  p.wsp = (bf*)take((size_t)2 * 4 * 128 * 128 * 2);
  p.m1 = (bf*)take(128 * 128 * 2);
  p.m2 = (bf*)take(128 * 256 * 2);
  p.mctx = (bf*)take(256 * 512 * 2);
  p.hN = (bf*)take((size_t)ROWS * D * 2);
  p.P = (bf*)take((size_t)57 * HROWS * 128 * 2);
  p.abuf = (bf*)take((size_t)2 * 64 * 2 * 128 * 512 * 2);
  p.ybuf = (bf*)take((size_t)HROWS * D * 2);
  p.cbuf = (bf*)take((size_t)2 * 256 * 512 * 2);
  p.mod = (float*)take(2 * 5 * 3072 * 4);
  p.tw = (float*)take(128 * 64 * 8);
  p.Q = (float*)take((size_t)2 * 4 * 128 * 256 * 4);
  p.gates = (float*)take((size_t)HROWS * 32 * 4);
  p.states = (bf*)take((size_t)32 * 66 * 8192 * 2);
  p.nbuf = (float*)take((size_t)32 * 66 * 64 * 4);
  p.scal = (float*)take(32 * 66 * 2 * 4);
  p.mstart = (float*)take(32 * 66 * 4);
  p.xc1 = (float*)take((size_t)1024 * 1024 * 4);
  p.bar = (unsigned*)take((size_t)XCD_BAR_WORDS * 4);
  if (off > ws_size) {
    fprintf(stderr, "workspace too small: need %zu have %zu\n", off, ws_size);
    return;
  }
  if (hipMemsetAsync(p.bar, 0, (size_t)XCD_BAR_WORDS * 4, stream) != hipSuccess) fprintf(stderr, "memset failed\n");
  void* args[] = {&p};
  hipError_t e = hipLaunchCooperativeKernel((const void*)mk_forward, dim3(grid_blocks), dim3(256), args, LDS_BYTES, stream);
  if (e != hipSuccess) fprintf(stderr, "cooperative launch failed: %s (grid %d)\n", hipGetErrorString(e), grid_blocks);
}
```

```cpp
#include <hip/hip_runtime.h>
#include <hip/hip_cooperative_groups.h>
#include <cstdio>
namespace cg = cooperative_groups;

typedef unsigned short bf;
typedef __attribute__((ext_vector_type(8))) short bf16x8;
typedef __attribute__((ext_vector_type(16))) float f32x16;

#define DEV __device__ __forceinline__

constexpr int D = 1024, TB = 8448, ROWS = 33792, HROWS = 16896;
constexpr int NP = 7200, NPW = 7296, NIN = 6688;
constexpr int CQ = 0, CK = 512, CV = 1024, CO = 2048, CZA = 3072, CU = 4096, CVS = 4608, CZB = 5120,
              CHR = 5632, CZC = 6144, CHI = 6656, CG = 7168;
constexpr int SRC_G = 2048, SRC_F = 5664;
constexpr int SSLOT = 8256;
constexpr float EPS = 1e-6f;
constexpr int BKP = 40;
constexpr int LDS_BYTES = 80896;
constexpr int OFF_SB = 36864, OFF_SB32 = 20480, OFF_SL = 40960, OFF_VEC = 75776;

struct Params {
  const float *x, *c, *ctx, *c_ctx, *w_mod, *b_mod, *g_pre, *g_post, *w_in, *b_gate, *g_hnorm, *g_sgu, *w_sp, *b_sp,
      *w_fno, *b_fno, *w_out;
  float* out;
  bf *wt_in, *wt_out, *wsp, *m1, *m2, *mctx, *hN, *P, *abuf, *ybuf, *cbuf, *states;
  float *mod, *tw, *Q, *gates, *nbuf, *scal, *mstart, *xc1;
  unsigned* bar;
};

typedef __attribute__((ext_vector_type(2))) __bf16 bf16x2_t;
typedef __attribute__((ext_vector_type(2))) float f32x2_t;
DEV unsigned pack2(float a, float b) {
  f32x2_t f = {a, b};
  bf16x2_t h = __builtin_convertvector(f, bf16x2_t);
  return __builtin_bit_cast(unsigned, h);
}
DEV bf f2bf(float f) { return (bf)(pack2(f, f) & 0xffffu); }
DEV float bf2f(bf h) { return __uint_as_float(((unsigned)h) << 16); }
DEV float lo2f(unsigned u) { return __uint_as_float(u << 16); }
DEV float hi2f(unsigned u) { return __uint_as_float(u & 0xffff0000u); }
DEV int otid() {
  int t = threadIdx.x;
  asm volatile("" : "+v"(t));
  return t;
}
DEV int obid() {
  int b = blockIdx.x;
  asm volatile("" : "+s"(b));
  return b;
}
DEV unsigned pidx(int row, int col) { return (unsigned)(((col >> 7) * HROWS + row) * 128 + (col & 127)); }
typedef __attribute__((ext_vector_type(4))) float f32x4v;
DEV float4 nt_load4(const float* p) {
  f32x4v v = __builtin_nontemporal_load((const f32x4v*)p);
  return make_float4(v[0], v[1], v[2], v[3]);
}
DEV void nt_store4(float* p, float4 o) {
  f32x4v v = {o.x, o.y, o.z, o.w};
  __builtin_nontemporal_store(v, (f32x4v*)p);
}
DEV float silu(float x) { return x * __builtin_amdgcn_rcpf(1.f + __expf(-x)); }
DEV float sigm(float x) { return __builtin_amdgcn_rcpf(1.f + __expf(-x)); }
DEV float logsigmoid(float x) {
  float y = __expf(-fabsf(x));
  float l1p = (y < 0.03125f) ? y * (1.f - y * (0.5f - y * (0.33333334f - 0.25f * y))) : __logf(1.f + y);
  return fminf(x, 0.f) - l1p;
}

typedef __attribute__((ext_vector_type(4))) unsigned u32x4;
typedef __attribute__((ext_vector_type(4))) short s16x4;
DEV bf16x8 tr_frag(const bf* p, int ld) {
  typedef __attribute__((address_space(3))) s16x4 lds_s16x4;
  s16x4 t0 = __builtin_amdgcn_ds_read_tr16_b64_v4i16((lds_s16x4*)p);
  s16x4 t1 = __builtin_amdgcn_ds_read_tr16_b64_v4i16((lds_s16x4*)(p + 4 * ld));
  bf16x8 f = {t0[0], t0[1], t0[2], t0[3], t1[0], t1[1], t1[2], t1[3]};
  return f;
}
template <int BM, int BN, int BK, bool ATOK, bool BTOK, bool PF2 = false, class FA, class FB>
DEV void block_gemm(f32x16 (&acc)[BM / 64][BN / 64], FA getA, FB getB, int nkt, bf* sA, bf* sB, bool zero = true) {
  constexpr int MT = BM / 64, NTl = BN / 64, KV = BK / 8, NA = BM * KV / 256, NB = BN * KV / 256;
  constexpr int LDK = BK + 8;
  constexpr int LDAT = BM + 8, LDBT = BN + 8;
  constexpr int XBUFA = ATOK ? BK * LDAT : BM * LDK, XBUFB = BTOK ? BK * LDBT : BN * LDK;
  const int tid = otid(), lane = tid & 63, w = tid >> 6, wm = w >> 1, wn = w & 1;
  uint4 ra[NA], rb[NB];
  if (zero) {
#pragma unroll
    for (int i = 0; i < MT; i++)
#pragma unroll
      for (int j = 0; j < NTl; j++)
#pragma unroll
        for (int r = 0; r < 16; r++) acc[i][j][r] = 0.f;
  }

#define BG_FETCH(kt, RA, RB)                                                          \
  {                                                                                   \
    _Pragma("unroll") for (int i = 0; i < NA; i++) {                                  \
      int idx = tid + 256 * i;                                                        \
      if (ATOK) RA[i] = getA((kt), idx / (BM / 8), (idx % (BM / 8)) * 8);              \
      else RA[i] = getA((kt), idx / KV, (idx % KV) * 8);                              \
    }                                                                                 \
    _Pragma("unroll") for (int i = 0; i < NB; i++) {                                  \
      int idx = tid + 256 * i;                                                        \
      if (BTOK) RB[i] = getB((kt), idx / (BN / 8), (idx % (BN / 8)) * 8);              \
      else RB[i] = getB((kt), idx / KV, (idx % KV) * 8);                              \
    }                                                                                 \
  }
#define BG_STASH(buf, RA, RB)                                                         \
  {                                                                                   \
    _Pragma("unroll") for (int i = 0; i < NA; i++) {                                  \
      int idx = tid + 256 * i;                                                        \
      if (ATOK) *(uint4*)(sA + (buf) * XBUFA + (idx / (BM / 8)) * LDAT + (idx % (BM / 8)) * 8) = RA[i]; \
      else *(uint4*)(sA + (buf) * XBUFA + (idx / KV) * LDK + (idx % KV) * 8) = RA[i];  \
    }                                                                                 \
    _Pragma("unroll") for (int i = 0; i < NB; i++) {                                  \
      int idx = tid + 256 * i;                                                        \
      if (BTOK) *(uint4*)(sB + (buf) * XBUFB + (idx / (BN / 8)) * LDBT + (idx % (BN / 8)) * 8) = RB[i]; \
      else *(uint4*)(sB + (buf) * XBUFB + (idx / KV) * LDK + (idx % KV) * 8) = RB[i];  \
    }                                                                                 \
  }
#define BG_COMPUTE(buf)                                                               \
  _Pragma("unroll") for (int ks = 0; ks < BK / 16; ks++) {                            \
    bf16x8 a[MT], b[NTl];                                                             \
    _Pragma("unroll") for (int i = 0; i < MT; i++) {                                  \
      if (ATOK) {                                                                     \
        a[i] = tr_frag(sA + (buf) * XBUFA + (ks * 16 + (lane >> 5) * 8 + ((lane & 15) >> 2)) * LDAT + wm * (BM / 2) + i * 32 + \
                       ((lane >> 4) & 1) * 16 + (lane & 3) * 4, LDAT);                \
      } else {                                                                        \
        a[i] = *(const bf16x8*)(sA + (buf) * XBUFA + (wm * (BM / 2) + i * 32 + (lane & 31)) * LDK + ks * 16 + (lane >> 5) * 8); \
      }                                                                               \
    }                                                                                 \
    _Pragma("unroll") for (int j = 0; j < NTl; j++) {                                 \
      if (BTOK) {                                                                     \
        b[j] = tr_frag(sB + (buf) * XBUFB + (ks * 16 + (lane >> 5) * 8 + ((lane & 15) >> 2)) * LDBT + wn * (BN / 2) + j * 32 + \
                       ((lane >> 4) & 1) * 16 + (lane & 3) * 4, LDBT);                \
      } else {                                                                        \
        b[j] = *(const bf16x8*)(sB + (buf) * XBUFB + (wn * (BN / 2) + j * 32 + (lane & 31)) * LDK + ks * 16 + (lane >> 5) * 8); \
      }                                                                               \
    }                                                                                 \
    _Pragma("unroll") for (int i = 0; i < MT; i++)                                    \
      _Pragma("unroll") for (int j = 0; j < NTl; j++)                                 \
        acc[i][j] = __builtin_amdgcn_mfma_f32_32x32x16_bf16(a[i], b[j], acc[i][j], 0, 0, 0); \
    if (!ATOK && !BTOK) __builtin_amdgcn_iglp_opt(0);                                 \
  }

  if (PF2) {
    uint4 ra2[NA], rb2[NB];
    BG_FETCH(0, ra, rb);
    BG_FETCH(1, ra2, rb2);
    BG_STASH(0, ra, rb);
    __syncthreads();
#pragma unroll 1
    for (int kt = 0; kt < nkt; kt += 2) {
      const int k2 = min(kt + 2, nkt - 1), k3 = min(kt + 3, nkt - 1);
      BG_FETCH(k2, ra, rb);
      BG_COMPUTE(0);
      BG_STASH(1, ra2, rb2);
      __syncthreads();
      BG_FETCH(k3, ra2, rb2);
      BG_COMPUTE(1);
      BG_STASH(0, ra, rb);
      __syncthreads();
    }
  } else {
    BG_FETCH(0, ra, rb);
    BG_STASH(0, ra, rb);
    __syncthreads();
#pragma unroll 1
    for (int kt = 0; kt < nkt; kt++) {
      const int buf = kt & 1;
      if (kt + 1 < nkt) BG_FETCH(kt + 1, ra, rb);
      BG_COMPUTE(buf);
      if (kt + 1 < nkt) BG_STASH(buf ^ 1, ra, rb);
      __syncthreads();
    }
  }
#undef BG_FETCH
#undef BG_STASH
#undef BG_COMPUTE
}

template <int BM, class FD>
DEV void store_tile_bf16(f32x16 (&acc)[BM / 64][2], bf* Cs, FD dst, int ncols_valid) {
  acc_foreach<BM, 128>(acc, [&](int row, int col, float v) { Cs[row * 136 + col] = f2bf(v); });
  __syncthreads();
  const int tid = otid();
#pragma unroll 4
  for (int i = 0; i < BM / 16; i++) {
    int idx = tid + 256 * i;
    int row = idx >> 4, c8 = (idx & 15) * 8;
    uint4 v = *(const uint4*)(Cs + row * 136 + c8);
    if (c8 < ncols_valid) *(uint4*)(dst(row) + c8) = v;
  }
  __syncthreads();
}

DEV uint4 scale8(uint4 q, float sc) {
  return make_uint4(pack2(lo2f(q.x) * sc, hi2f(q.x) * sc), pack2(lo2f(q.y) * sc, hi2f(q.y) * sc),
                    pack2(lo2f(q.z) * sc, hi2f(q.z) * sc), pack2(lo2f(q.w) * sc, hi2f(q.w) * sc));
}

template <int BM, int BN, class F>
DEV void acc_foreach(f32x16 (&acc)[BM / 64][BN / 64], F f) {
  const int tid_ = otid();
  const int lane = tid_ & 63, w = tid_ >> 6, wm = w >> 1, wn = w & 1;
#pragma unroll
  for (int i = 0; i < BM / 64; i++)
#pragma unroll
    for (int j = 0; j < BN / 64; j++)
#pragma unroll
      for (int r = 0; r < 16; r++) {
        int row = wm * (BM / 2) + i * 32 + (r & 3) + 8 * (r >> 2) + 4 * (lane >> 5);
        int col = wn * (BN / 2) + j * 32 + (lane & 31);
        f(row, col, acc[i][j][r]);
        if (r == 15) asm volatile("" ::: "memory");
      }
}

DEV void conv_tile(const float* __restrict__ src, int srcld, int sn0, int nvalid, bf* __restrict__ dst, int dstld, int n0, int k0,
                   float* tile) {
  const int tid = otid();
  {
    float4 v[4];
#pragma unroll
    for (int i = 0; i < 4; i++) {
      int idx = tid + 256 * i;
      int kk = idx >> 4, n4 = (idx & 15) * 4;
      v[i] = make_float4(0.f, 0.f, 0.f, 0.f);
      if (n4 < nvalid) v[i] = *(const float4*)(src + (size_t)(k0 + kk) * srcld + sn0 + n4);
    }
#pragma unroll
    for (int i = 0; i < 4; i++) {
      int idx = tid + 256 * i;
      int kk = idx >> 4, n4 = (idx & 15) * 4;
      tile[kk * 65 + n4] = v[i].x; tile[kk * 65 + n4 + 1] = v[i].y; tile[kk * 65 + n4 + 2] = v[i].z; tile[kk * 65 + n4 + 3] = v[i].w;
    }
  }
  __syncthreads();
#pragma unroll 4
  for (int i = 0; i < 16; i++) {
    int idx = tid + 256 * i;
    int nn = idx >> 6, kk = idx & 63;
    int n = n0 + nn;
    dst[(size_t)n * dstld + k0 + kk] = f2bf(tile[kk * 65 + nn]);
  }
  __syncthreads();
}

DEV void phase0a(const Params& p, unsigned char* smem) {
  const int tid = otid();
  float* fs = (float*)smem;
  for (int it = obid(); it < 2 * 114 * 16; it += gridDim.x) {
    int kt = it & 15, nt = (it >> 4) % 114, l = it / (114 * 16);
    const int n0 = nt * 64;
    int sn0 = n0, nvalid = 64;
    if (n0 < 2048) sn0 = n0;
    else if (n0 < CHR) sn0 = n0 + 32;
    else if (n0 < CZC) continue;
    else if (n0 < CHI) sn0 = n0 + 32;
    else if (n0 < CG) continue;
    else if (n0 == CG) { sn0 = SRC_G; nvalid = 32; }
    else { sn0 = 0; nvalid = 0; }
    conv_tile(p.w_in + (size_t)l * D * NIN, NIN, sn0, nvalid, p.wt_in + (size_t)l * NPW * D, D, n0, kt * 64, fs);
  }
  for (int it = obid(); it < 2 * 16 * 32; it += gridDim.x) {
    int kt = it & 31, nt = (it >> 5) & 15, l = it >> 9;
    conv_tile(p.w_out + (size_t)l * 2048 * D, D, nt * 64, 64, p.wt_out + (size_t)l * D * 2048, 2048, nt * 64, kt * 64, fs);
  }
  for (int it = obid(); it < 96; it += gridDim.x) {
    int l = it / 48, j0 = (it % 48) * 64;
    float* sc = fs;
    float* red = fs + 5 * 1024;
    for (int i = tid; i < 5 * 1024; i += 256) {
      int v = i >> 10, k = i & 1023;
      float cv = (v < 4) ? p.c[v * D + k] : p.c_ctx[k];
      sc[i] = silu(cv);
    }
    __syncthreads();
    int col = tid & 63, ks = tid >> 6;
    float a0 = 0, a1 = 0, a2 = 0, a3 = 0, a4 = 0;
    const float* wp = p.w_mod + (size_t)l * D * 3072 + j0 + col;
#pragma unroll 16
    for (int k = ks * 256; k < ks * 256 + 256; k++) {
      float wv = wp[(size_t)k * 3072];
      a0 += sc[k] * wv; a1 += sc[1024 + k] * wv; a2 += sc[2048 + k] * wv; a3 += sc[3072 + k] * wv; a4 += sc[4096 + k] * wv;
    }
    red[(ks * 5 + 0) * 64 + col] = a0; red[(ks * 5 + 1) * 64 + col] = a1; red[(ks * 5 + 2) * 64 + col] = a2;
    red[(ks * 5 + 3) * 64 + col] = a3; red[(ks * 5 + 4) * 64 + col] = a4;
    __syncthreads();
    for (int i = tid; i < 5 * 64; i += 256) {
      int v = i >> 6, cc = i & 63;
      float s = red[(0 * 5 + v) * 64 + cc] + red[(1 * 5 + v) * 64 + cc] + red[(2 * 5 + v) * 64 + cc] + red[(3 * 5 + v) * 64 + cc];
      p.mod[(l * 5 + v) * 3072 + j0 + cc] = s + p.b_mod[l * 3072 + j0 + cc];
    }
    __syncthreads();
  }
  const int gtid = obid() * 256 + tid, gsz = gridDim.x * 256;
  for (int i = gtid; i < 2 * 4 * 128 * 128; i += gsz) p.wsp[i] = f2bf(p.w_sp[i]);
  for (int i = gtid; i < 128 * 128; i += gsz) {
    int m = i >> 7, k = i & 127;
    int wmm = m >> 6, rip = (m >> 5) & 1, k1 = wmm * 32 + (m & 31);
    int ri = k >> 6, t1 = k & 63;
    float s, c;
    sincospif((float)((k1 * t1) & 63) / 32.f, &s, &c);
    float v = rip == 0 ? (ri == 0 ? c : s) : (ri == 0 ? -s : c);
    p.m1[i] = f2bf(v);
  }
  for (int i = gtid; i < 128 * 256; i += gsz) {
    int k2 = i >> 8, k = i & 255;
    int ri = k >> 7, t2 = k & 127;
    float s, c;
    sincospif((float)((t2 * k2) & 127) / 64.f, &s, &c);
    p.m2[i] = f2bf(ri == 0 ? c : s);
  }
  for (int i = gtid; i < 256 * 512; i += gsz) {
    int tp = i >> 9, k = i & 511;
    int ri = k >> 8, t = k & 255;
    float s, c;
    sincospif((float)((t * tp) & 255) / 128.f, &s, &c);
    p.mctx[i] = f2bf(ri == 0 ? c : s);
  }
  for (int i = gtid; i < 128 * 64; i += gsz) {
    int t2 = i >> 6, k1 = i & 63;
    float s, c;
    sincospif((float)(t2 * k1) / 4096.f, &s, &c);
    p.tw[2 * i] = c;
    p.tw[2 * i + 1] = s;
  }
  __syncthreads();
  if (tid < 128) {
    float s, co;
    sincospif((float)tid / 64.f, &s, &co);
    fs[tid] = co;
    fs[128 + tid] = -s;
  }
  __syncthreads();
  for (int i = gtid; i < 2 * 4 * 128 * 256; i += gsz) {
    int d = i & 127, ri = (i >> 7) & 1, c = (i >> 8) & 127, lg = i >> 15;
    const float* wf = p.w_fno + (size_t)lg * 128 * 128 + d;
    const float* tr = fs + ri * 128;
    float acc = 0.f;
#pragma unroll 8
    for (int cp = 0; cp < 128; cp++) acc += tr[(c * cp) & 127] * wf[cp * 128];
    p.Q[i] = acc * 0.08838834764831845f;
  }
}

DEV void phase0b(const Params& p, unsigned char* smem) {
  const int tid = otid();
  float* wl = (float*)smem;
  for (int it = obid(); it < 256; it += gridDim.x) {
    int l = it >> 7, k0 = (it & 127) * 8;
    const float* wsrc = p.w_in + (size_t)l * D * NIN + (size_t)k0 * NIN + SRC_F;
    {
      float4 wv4[4];
#pragma unroll
      for (int i = 0; i < 4; i++) {
        int idx = tid + 256 * i;
        int kk = idx >> 7, f4 = (idx & 127) * 4;
        wv4[i] = *(const float4*)(wsrc + (size_t)kk * NIN + f4);
      }
#pragma unroll
      for (int i = 0; i < 4; i++) {
        int idx = tid + 256 * i;
        int kk = idx >> 7, f4 = (idx & 127) * 4;
        wl[(f4 + 0) * 8 + kk] = wv4[i].x; wl[(f4 + 1) * 8 + kk] = wv4[i].y; wl[(f4 + 2) * 8 + kk] = wv4[i].z; wl[(f4 + 3) * 8 + kk] = wv4[i].w;
      }
    }
    __syncthreads();
    for (int jj = 0; jj < 4; jj++) {
      int np = tid + 256 * jj;
      int d = np & 127, g = (np >> 7) & 3, ri = np >> 9;
      float acc[8];
#pragma unroll
      for (int kk = 0; kk < 8; kk++) acc[kk] = 0.f;
      const float* qp = p.Q + ((size_t)(l * 4 + g) * 128) * 256 + ri * 128 + d;
      const float* wp = wl + g * 128 * 8;
#pragma unroll 16
      for (int c = 0; c < 128; c++) {
        float qv = qp[c * 256];
        float4 w0 = *(const float4*)(wp + c * 8), w1 = *(const float4*)(wp + c * 8 + 4);
        acc[0] += w0.x * qv; acc[1] += w0.y * qv; acc[2] += w0.z * qv; acc[3] += w0.w * qv;
        acc[4] += w1.x * qv; acc[5] += w1.y * qv; acc[6] += w1.z * qv; acc[7] += w1.w * qv;
      }
      int n = (ri ? CHI : CHR) + g * 128 + d;
      uint4 o = make_uint4(pack2(acc[0], acc[1]), pack2(acc[2], acc[3]), pack2(acc[4], acc[5]), pack2(acc[6], acc[7]));
      *(uint4*)(p.wt_in + ((size_t)l * NPW + n) * D + k0) = o;
    }
    __syncthreads();
  }
}

DEV void phase1(const Params& p, int l) {
  const int lane = otid() & 63, w = otid() >> 6;
  for (int r = obid() * 4 + w; r < ROWS; r += gridDim.x * 4) {
    int b = r / TB, j = r % TB;
    const float* xin;
    int mv;
    if (j < 256) {
      xin = (l == 0 ? p.ctx : p.xc1) + ((size_t)b * 256 + j) * D;
      mv = 4;
    } else {
      xin = (l == 0 ? p.x : p.out) + ((size_t)b * 8192 + (j - 256)) * D;
      mv = b;
    }
    const float* md = p.mod + (size_t)(l * 5 + mv) * 3072;
    float4 v[4];
    float ss = 0.f;
#pragma unroll
    for (int i = 0; i < 4; i++) {
      v[i] = nt_load4(xin + lane * 4 + 256 * i);
      ss += v[i].x * v[i].x + v[i].y * v[i].y + v[i].z * v[i].z + v[i].w * v[i].w;
    }
#pragma unroll
    for (int off = 32; off; off >>= 1) ss += __shfl_xor(ss, off);
    float rstd = rsqrtf(ss * (1.f / 1024.f) + EPS);
#pragma unroll
    for (int i = 0; i < 4; i++) {
      int col = lane * 4 + 256 * i;
      float4 g = *(const float4*)(p.g_pre + l * D + col);
      float4 sh = *(const float4*)(md + col);
      float4 sc = *(const float4*)(md + 1024 + col);
      float o0 = v[i].x * rstd * g.x * (1.f + sc.x) + sh.x;
      float o1 = v[i].y * rstd * g.y * (1.f + sc.y) + sh.y;
      float o2 = v[i].z * rstd * g.z * (1.f + sc.z) + sh.z;
      float o3 = v[i].w * rstd * g.w * (1.f + sc.w) + sh.w;
      *(uint2*)(p.hN + (size_t)r * D + col) = make_uint2(pack2(o0, o1), pack2(o2, o3));
    }
  }
}

DEV void phase2(const Params& p, int l, int hf, unsigned char* smem) {
  bf* sA = (bf*)smem;
  bf* sB = (bf*)(smem + 40960);
  const int bid = obid();
  const int nxb = gridDim.x >> 3, xcd = bid & 7, lb = bid >> 3;
  const int per = (66 * 57 + 7) / 8;
  const int tend = min((xcd + 1) * per, 66 * 57);
  for (int t = xcd * per + lb; t < tend; t += nxb) {
    int ms, rem, rows_in;
    if (t < 8 * 8 * 57) { ms = t / 456; rem = t - ms * 456; rows_in = 8; }
    else { ms = 8; rem = t - 8 * 456; rows_in = 2; }
    int ns = rem / (rows_in * 8);
    if (ns > 7) ns = 7;
    int r2 = rem - ns * rows_in * 8;
    int mt = ms * 8 + (r2 % rows_in), nt = ns * 8 + (r2 / rows_in);
    const bf* A = p.hN + ((size_t)hf * HROWS + mt * 256) * D;
    const bf* B = p.wt_in + ((size_t)l * NPW + nt * 128) * D;
    f32x16 acc[4][2];
    auto gA = [&](int kt, int r, int ko) -> uint4 { return *(const uint4*)(A + (unsigned)(r * D + kt * 32 + ko)); };
    auto gB = [&](int kt, int r, int ko) -> uint4 { return *(const uint4*)(B + (unsigned)(r * D + kt * 32 + ko)); };
    block_gemm<256, 128, 32, false, false, true>(acc, gA, gB, 32, sA, sB);
    if (nt == CG / 128) {
      acc_foreach<256, 128>(acc, [&](int row, int col, float v) {
        if (col < 32) p.gates[(unsigned)((mt * 256 + row) * 32 + col)] = v + p.b_gate[l * 32 + col];
      });
    }
    store_tile_bf16<256>(acc, (bf*)smem, [&](int row) -> bf* { return p.P + pidx(mt * 256 + row, nt * 128); }, min(128, NP - nt * 128));
  }
}

DEV void gate_prep(const float* __restrict__ gch, int h, float* vec, bool want_w) {
  const int tid = otid(), lane = tid & 63, w = tid >> 6;
  if (w < 2) {
    const int d = w;
    int p0 = 2 * lane, p1 = p0 + 1;
    int i0 = d ? 127 - p0 : p0, i1 = d ? 127 - p1 : p1;
    float ig0 = gch[i0 * 32 + (2 * d) * 8 + h], ig1 = gch[i1 * 32 + (2 * d) * 8 + h];
    float lf0 = logsigmoid(gch[i0 * 32 + (2 * d + 1) * 8 + h]), lf1 = logsigmoid(gch[i1 * 32 + (2 * d + 1) * 8 + h]);
    float incl = lf0 + lf1;
#pragma unroll
    for (int off = 1; off < 64; off <<= 1) {
      float t = __shfl_up(incl, off);
      if (lane >= off) incl += t;
    }
    float b1 = incl, b0 = incl - lf1;
    float a0 = ig0 - b0, a1 = ig1 - b1;
    float mincl = fmaxf(a0, a1);
#pragma unroll
    for (int off = 1; off < 64; off <<= 1) {
      float t = __shfl_up(mincl, off);
      if (lane >= off) mincl = fmaxf(mincl, t);
    }
    float prev = __shfl_up(mincl, 1);
    float pm0 = lane ? fmaxf(prev, a0) : a0, pm1 = mincl;
    float tot = __shfl(b1, 63);
    vec[d * 128 + i0] = ig0;
    vec[d * 128 + i1] = ig1;
    vec[256 + d * 128 + i0] = b0;
    vec[256 + d * 128 + i1] = b1;
    if (want_w) {
      float wl0 = tot - b0 + ig0, wl1 = tot - b1 + ig1;
      float mx = fmaxf(wl0, wl1);
#pragma unroll
      for (int off = 32; off; off >>= 1) mx = fmaxf(mx, __shfl_xor(mx, off));
      vec[512 + d * 128 + i0] = __expf(wl0 - mx);
      vec[512 + d * 128 + i1] = __expf(wl1 - mx);
      if (lane == 0) {
        vec[1152 + d * 2] = tot;
        vec[1152 + d * 2 + 1] = mx;
      }
    } else {
      vec[512 + d * 128 + i0] = pm0;
      vec[512 + d * 128 + i1] = pm1;
      if (lane == 0) vec[1152 + d * 2] = tot;
    }
  }
  __syncthreads();
}

DEV void mlstm_dc_item(const Params& p, int it, unsigned char* smem) {
  bf* sA = (bf*)smem;
  bf* sB = (bf*)(smem + OFF_SB);
  float* vec = (float*)(smem + OFF_VEC);
  const int tid = otid();
  int j = it % 66, h = (it / 66) & 7, bl = it / 528;
  size_t base = (size_t)bl * TB + j * 128;
  gate_prep(p.gates + base * 32, h, vec, true);
  const bf* Pb = p.P;
  const int rb = (int)base;
  for (int d = 0; d < 2; d++) {
    int sid = (bl * 8 + h) * 2 + d;
    bf* slot = p.states + ((size_t)sid * 66 + j) * 8192;
    float* nslot = p.nbuf + ((size_t)sid * 66 + j) * 64;
    const float* wv = vec + 512 + d * 128;
    f32x16 acc[1][2];
    auto gA = [&](int kt, int to, int c) -> uint4 {
      int tok = kt * 64 + to;
      return *(const uint4*)(Pb + pidx(rb + tok, CK + h * 64 + c));
    };
    auto gB = [&](int kt, int to, int c) -> uint4 {
      int tok = kt * 64 + to;
      return scale8(*(const uint4*)(Pb + pidx(rb + tok, CV + h * 128 + c)), wv[tok]);
    };
    block_gemm<64, 128, 64, true, true, true>(acc, gA, gB, 2, sA, sB);
    store_tile_bf16<64>(acc, (bf*)smem, [&](int row) -> bf* { return slot + row * 128; }, 128);
    {
      float* red = vec + 768;
      int dk = tid & 63, part = tid >> 6;
      float sacc = 0.f;
#pragma unroll 8
      for (int t = part * 32; t < part * 32 + 32; t++) sacc += wv[t] * bf2f(Pb[pidx(rb + t, CK + h * 64 + dk)]);
      red[part * 64 + dk] = sacc;
      __syncthreads();
      if (tid < 64) nslot[tid] = red[tid] + red[64 + tid] + red[128 + tid] + red[192 + tid];
    }
    if (tid == 0) {
      p.scal[(sid * 66 + j) * 2] = vec[1152 + d * 2];
      p.scal[(sid * 66 + j) * 2 + 1] = vec[1152 + d * 2 + 1];
    }
  }
  __syncthreads();
}

DEV void sgu_item(const Params& p, int l, int it, unsigned char* smem) {
  bf* sA = (bf*)smem;
  bf* sB = (bf*)(smem + OFF_SB);
  float* rstd = (float*)(smem + OFF_VEC);
  const int tid = otid();
  int g = it & 3, j = (it >> 2) % 66, bl = it / 264;
  size_t base = (size_t)bl * TB + j * 128;
  bf* Pb = p.P;
  const int rb = (int)base;
  {
    int t = tid >> 1, hh = tid & 1;
    float ss = 0.f;
    for (int i = 0; i < 32; i++) {
      uint4 u = *(const uint4*)(Pb + pidx(rb + t, CVS + hh * 256 + i * 8));
      float a;
      a = lo2f(u.x); ss += a * a; a = hi2f(u.x); ss += a * a;
      a = lo2f(u.y); ss += a * a; a = hi2f(u.y); ss += a * a;
      a = lo2f(u.z); ss += a * a; a = hi2f(u.z); ss += a * a;
      a = lo2f(u.w); ss += a * a; a = hi2f(u.w); ss += a * a;
    }
    ss += __shfl_xor(ss, 1);
    if (hh == 0) rstd[t] = rsqrtf(ss * (1.f / 512.f) + EPS);
  }
  __syncthreads();
  const bf* W = p.wsp + (size_t)(l * 4 + g) * 128 * 128;
  const float* gs = p.g_sgu + l * 512 + g * 128;
  f32x16 acc[2][2];
  auto gA = [&](int kt, int r, int ko) -> uint4 { return *(const uint4*)(W + r * 128 + kt * 64 + ko); };
  auto gB = [&](int kt, int to, int c) -> uint4 {
    int tok = kt * 64 + to;
    return scale8(*(const uint4*)(Pb + pidx(rb + tok, CVS + g * 128 + c)), rstd[tok]);
  };
  block_gemm<128, 128, 64, false, true, true>(acc, gA, gB, 2, sA, sB);
  const float* bs = p.b_sp + (size_t)(l * 4 + g) * 128;
  float* Hs = (float*)smem;
  acc_foreach<128, 128>(acc, [&](int t, int c, float v) { Hs[t * 132 + c] = v; });
  __syncthreads();
  {
    const int t = tid >> 1, hh = tid & 1;
    const float* hrow = Hs + t * 132 + hh * 64;
    const float* gp = gs + hh * 64;
    const float bt = bs[t];
#pragma unroll 2
    for (int i = 0; i < 8; i++) {
      bf* up = Pb + pidx(rb + t, CU + g * 128 + hh * 64 + i * 8);
      uint4 uu = *(const uint4*)up;
      uint4 uz = *(const uint4*)(Pb + pidx(rb + t, CZB + g * 128 + hh * 64 + i * 8));
      float4 h0 = *(const float4*)(hrow + i * 8), h1 = *(const float4*)(hrow + i * 8 + 4);
      float4 g0 = *(const float4*)(gp + i * 8), g1 = *(const float4*)(gp + i * 8 + 4);
      float y0 = lo2f(uu.x) * (h0.x * g0.x + bt) * silu(lo2f(uz.x));
      float y1 = hi2f(uu.x) * (h0.y * g0.y + bt) * silu(hi2f(uz.x));
      float y2 = lo2f(uu.y) * (h0.z * g0.z + bt) * silu(lo2f(uz.y));
      float y3 = hi2f(uu.y) * (h0.w * g0.w + bt) * silu(hi2f(uz.y));
      float y4 = lo2f(uu.z) * (h1.x * g1.x + bt) * silu(lo2f(uz.z));
      float y5 = hi2f(uu.z) * (h1.y * g1.y + bt) * silu(hi2f(uz.z));
      float y6 = lo2f(uu.w) * (h1.z * g1.z + bt) * silu(lo2f(uz.w));
      float y7 = hi2f(uu.w) * (h1.w * g1.w + bt) * silu(hi2f(uz.w));
      *(uint4*)up = make_uint4(pack2(y0, y1), pack2(y2, y3), pack2(y4, y5), pack2(y6, y7));
    }
  }
  __syncthreads();
}

DEV void fourA_item(const Params& p, int it, unsigned char* smem) {
  bf* sA = (bf*)smem;
  bf* sB = (bf*)(smem + OFF_SB);
  int cht = it & 3, t2 = (it >> 2) & 127, bl = it >> 9;
  const bf* Pb = p.P;
  const int rb = bl * TB + 256 + t2;
  f32x16 acc[2][2];
  auto gA = [&](int kt, int r, int ko) -> uint4 { return *(const uint4*)(p.m1 + r * 128 + kt * 64 + ko); };
  auto gB = [&](int kt, int to, int c) -> uint4 {
    int ri = kt, t1 = to;
    return *(const uint4*)(Pb + pidx(rb + t1 * 128, (ri ? CHI : CHR) + cht * 128 + c));
  };
  block_gemm<128, 128, 64, false, true, true>(acc, gA, gB, 2, sA, sB);
  float* Ha = (float*)smem;
  acc_foreach<128, 128>(acc, [&](int m, int c, float v) { Ha[m * 132 + c] = v; });
  __syncthreads();
  {
    const int tid = otid();
    const int k1 = tid >> 2, cq = (tid & 3) * 32;
    const float* ar = Ha + ((k1 >> 5) * 64 + (k1 & 31)) * 132 + cq;
    const float* ai = ar + 32 * 132;
    const float c = p.tw[(t2 * 64 + k1) * 2], sn = p.tw[(t2 * 64 + k1) * 2 + 1];
    bf* ore = p.abuf + ((((((size_t)bl * 64 + k1) * 4 + cht) * 2) * 128 + t2) * 128) + cq;
    bf* oim = ore + (size_t)128 * 128;
#pragma unroll
    for (int i = 0; i < 4; i++) {
      float4 r0 = *(const float4*)(ar + i * 8), r1 = *(const float4*)(ar + i * 8 + 4);
      float4 i0 = *(const float4*)(ai + i * 8), i1 = *(const float4*)(ai + i * 8 + 4);
      *(uint4*)(ore + i * 8) = make_uint4(pack2(r0.x * c + i0.x * sn, r0.y * c + i0.y * sn), pack2(r0.z * c + i0.z * sn, r0.w * c + i0.w * sn),
                                          pack2(r1.x * c + i1.x * sn, r1.y * c + i1.y * sn), pack2(r1.z * c + i1.z * sn, r1.w * c + i1.w * sn));
      *(uint4*)(oim + i * 8) = make_uint4(pack2(i0.x * c - r0.x * sn, i0.y * c - r0.y * sn), pack2(i0.z * c - r0.z * sn, i0.w * c - r0.w * sn),
                                          pack2(i1.x * c - r1.x * sn, i1.y * c - r1.y * sn), pack2(i1.z * c - r1.z * sn, i1.w * c - r1.w * sn));
    }
  }
  __syncthreads();
}

DEV void fourCtx_item(const Params& p, int l, int it, unsigned char* smem) {
  bf* sA = (bf*)smem;
  bf* sB = (bf*)(smem + OFF_SB);
  int mt = it & 1, g = (it >> 1) & 3, bl = it >> 3;
  const bf* Pb = p.P;
  const int rb = bl * TB;
  f32x16 acc[2][2];
  auto gA = [&](int kt, int r, int ko) -> uint4 { return *(const uint4*)(p.mctx + (mt * 128 + r) * 512 + kt * 64 + ko); };
  auto gB = [&](int kt, int to, int c) -> uint4 {
    int ri = kt >> 2, t = (kt & 3) * 64 + to;
    return *(const uint4*)(Pb + pidx(rb + t, (ri ? CHI : CHR) + g * 128 + c));
  };
  block_gemm<128, 128, 64, false, true, true>(acc, gA, gB, 8, sA, sB);
  float* Hs = (float*)smem;
  acc_foreach<128, 128>(acc, [&](int tl, int d, float v) { Hs[tl * 132 + d] = v; });
  __syncthreads();
  {
    const int tid = otid();
    const int tl = tid >> 1, hh = tid & 1;
    const int tp = mt * 128 + tl;
    const float* hrow = Hs + tl * 132 + hh * 64;
    const float* bp = p.b_fno + l * 512 + g * 128 + hh * 64;
    bf* op = p.cbuf + ((size_t)bl * 256 + tp) * 512 + g * 128 + hh * 64;
#pragma unroll 2
    for (int i = 0; i < 8; i++) {
      uint4 uz = *(const uint4*)(Pb + pidx(rb + tp, CZC + g * 128 + hh * 64 + i * 8));
      float4 h0 = *(const float4*)(hrow + i * 8), h1 = *(const float4*)(hrow + i * 8 + 4);
      float4 b0 = *(const float4*)(bp + i * 8), b1 = *(const float4*)(bp + i * 8 + 4);
      float y0 = (h0.x * 0.0625f + b0.x) * silu(lo2f(uz.x)), y1 = (h0.y * 0.0625f + b0.y) * silu(hi2f(uz.x));
      float y2 = (h0.z * 0.0625f + b0.z) * silu(lo2f(uz.y)), y3 = (h0.w * 0.0625f + b0.w) * silu(hi2f(uz.y));
      float y4 = (h1.x * 0.0625f + b1.x) * silu(lo2f(uz.z)), y5 = (h1.y * 0.0625f + b1.y) * silu(hi2f(uz.z));
      float y6 = (h1.z * 0.0625f + b1.z) * silu(lo2f(uz.w)), y7 = (h1.w * 0.0625f + b1.w) * silu(hi2f(uz.w));
      *(uint4*)(op + i * 8) = make_uint4(pack2(y0, y1), pack2(y2, y3), pack2(y4, y5), pack2(y6, y7));
    }
  }
  __syncthreads();
}

DEV void phase3(const Params& p, int l, unsigned char* smem) {
  const int n0 = 1056, n1 = n0 + 528, n2 = n1 + 1024, n3 = n2 + 16;
  for (int it = obid(); it < n3; it += gridDim.x) {
    if (it < n0) mlstm_dc_item(p, it, smem);
    else if (it < n1) sgu_item(p, l, it - n0, smem);
    else if (it < n2) fourA_item(p, it - n1, smem);
    else fourCtx_item(p, l, it - n2, smem);
  }
}

DEV int chunk_at(int d, int pp) { return d ? (pp == 0 ? 1 : (pp == 1 ? 0 : 67 - pp)) : pp; }
DEV void scan_item(const Params& p, int it, unsigned char* smem) {
  float* tab = (float*)(smem + OFF_VEC);
  const int tid = otid();
  int eb = it & 15, sid = it >> 4;
  int d = sid & 1;
  if (tid < 66) {
    int j = chunk_at(d, tid);
    tab[256 + tid] = p.scal[(sid * 66 + j) * 2];
    tab[384 + tid] = p.scal[(sid * 66 + j) * 2 + 1];
  }
  __syncthreads();
  if (tid == 0) {
    float m = 0.f;
    for (int pp = 0; pp < 66; pp++) {
      float bl_ = tab[256 + pp], ml = tab[384 + pp];
      float mn = fmaxf(bl_ + m, ml);
      tab[pp] = __expf(bl_ + m - mn);
      tab[128 + pp] = __expf(ml - mn);
      if (eb == 0) p.mstart[sid * 66 + chunk_at(d, pp)] = m;
      m = mn;
    }
  }
  __syncthreads();
  {
    float v0 = 0.f, v1 = 0.f;
    unsigned* basep = (unsigned*)(p.states + (size_t)sid * 66 * 8192) + eb * 256 + tid;
#pragma unroll 1
    for (int pb = 0; pb < 66; pb += 33) {
      unsigned dv[33];
#pragma unroll
      for (int u = 0; u < 33; u++) dv[u] = basep[(size_t)chunk_at(d, pb + u) * 4096];
#pragma unroll
      for (int u = 0; u < 33; u++) {
        basep[(size_t)chunk_at(d, pb + u) * 4096] = pack2(v0, v1);
        float de = tab[pb + u], sc = tab[128 + pb + u];
        v0 = de * v0 + sc * lo2f(dv[u]);
        v1 = de * v1 + sc * hi2f(dv[u]);
      }
    }
  }
  if (eb == 0 && tid < 64) {
    float val = 0.f;
    float* basep = p.nbuf + (size_t)sid * 66 * 64 + tid;
#pragma unroll 1
    for (int pb = 0; pb < 66; pb += 33) {
      float dv[33];
#pragma unroll
      for (int u = 0; u < 33; u++) dv[u] = basep[chunk_at(d, pb + u) * 64];
#pragma unroll
      for (int u = 0; u < 33; u++) {
        basep[chunk_at(d, pb + u) * 64] = val;
        val = tab[pb + u] * val + tab[128 + pb + u] * dv[u];
      }
    }
  }
  __syncthreads();
}

DEV void fourC_item(const Params& p, int l, int it, unsigned char* smem) {
  bf* sA = (bf*)smem;
  bf* sB = (bf*)(smem + OFF_SB);
  int g = it & 3, k1 = (it >> 2) & 63, bl = it >> 8;
  const bf* Ab = p.abuf + ((((size_t)bl * 64 + k1) * 4 + g) * 2) * 128 * 128;
  f32x16 acc[2][2];
  auto gA = [&](int kt, int r, int ko) -> uint4 { return *(const uint4*)(p.m2 + r * 256 + kt * 64 + ko); };
  auto gB = [&](int kt, int to, int c) -> uint4 {
    int kk = kt * 64 + to;
    return *(const uint4*)(Ab + (unsigned)(kk * 128 + c));
  };
  block_gemm<128, 128, 64, false, true, true>(acc, gA, gB, 4, sA, sB);
  bf* Pb = p.P;
  const int rb = bl * TB + 256;
  float* Hs = (float*)smem;
  acc_foreach<128, 128>(acc, [&](int k2, int d, float v) { Hs[k2 * 132 + d] = v; });
  __syncthreads();
  {
    const int tid = otid();
    const int k2 = tid >> 1, hh = tid & 1;
    const int tp = k1 + 64 * k2;
    const float* hrow = Hs + k2 * 132 + hh * 64;
    const float* bp = p.b_fno + l * 512 + g * 128 + hh * 64;
    const float sc = 0.011048543456039806f;
#pragma unroll 2
    for (int i = 0; i < 8; i++) {
      uint4 uz = *(const uint4*)(Pb + pidx(rb + tp, CZC + g * 128 + hh * 64 + i * 8));
      bf* op = Pb + pidx(rb + tp, CHR + g * 128 + hh * 64 + i * 8);
      float4 h0 = *(const float4*)(hrow + i * 8), h1 = *(const float4*)(hrow + i * 8 + 4);
      float4 b0 = *(const float4*)(bp + i * 8), b1 = *(const float4*)(bp + i * 8 + 4);
      float y0 = (h0.x * sc + b0.x) * silu(lo2f(uz.x)), y1 = (h0.y * sc + b0.y) * silu(hi2f(uz.x));
      float y2 = (h0.z * sc + b0.z) * silu(lo2f(uz.y)), y3 = (h0.w * sc + b0.w) * silu(hi2f(uz.y));
      float y4 = (h1.x * sc + b1.x) * silu(lo2f(uz.z)), y5 = (h1.y * sc + b1.y) * silu(hi2f(uz.z));
      float y6 = (h1.z * sc + b1.z) * silu(lo2f(uz.w)), y7 = (h1.w * sc + b1.w) * silu(hi2f(uz.w));
      *(uint4*)op = make_uint4(pack2(y0, y1), pack2(y2, y3), pack2(y4, y5), pack2(y6, y7));
    }
  }
  __syncthreads();
}

DEV void phase4(const Params& p, int l, unsigned char* smem) {
  const int n0 = 512, n1 = n0 + 32 * 16;
  for (int it = obid(); it < n1; it += gridDim.x) {
    if (it < n0) fourC_item(p, l, it, smem);
    else scan_item(p, it - n0, smem);
  }
  for (int i = obid() * 256 + otid(); i < 2 * 256 * 512; i += gridDim.x * 256) {
    int c = i & 511, t = (i >> 9) & 255, bl = i >> 17;
    p.P[pidx(bl * TB + t, CHR + c)] = p.cbuf[i];
  }
}

DEV void mlstm_out_item(const Params& p, int l, int it, unsigned char* smem) {
  bf* sA = (bf*)smem;
  bf* sB = (bf*)(smem + OFF_SB32);
  bf* Sl = (bf*)(smem + OFF_SL);
  float* vec = (float*)(smem + OFF_VEC);
  float* mrow = vec + 768;
  float* winter = vec + 896;
  float* dinv = vec + 1024;
  float* nst = vec + 1160;
  const int tid = otid(), lane = tid & 63, w = tid >> 6, wm = w >> 1, wn = w & 1;
  int j, h, bl;
  if (l == 0) { j = it % 66; h = (it / 66) & 7; bl = it / 528; }
  else { j = 2 + (it & 63); h = (it >> 6) & 7; bl = it >> 9; }
  size_t base = (size_t)bl * TB + j * 128;
  gate_prep(p.gates + base * 32, h, vec, false);
  bf* Pb = p.P;
  const int rb = (int)base;
  f32x16 acch[2][2];
  for (int d = 0; d < 2; d++) {
    int sid = (bl * 8 + h) * 2 + d;
    const bf* slot = p.states + ((size_t)sid * 66 + j) * 8192;
    const float* nslot = p.nbuf + ((size_t)sid * 66 + j) * 64;
    const float* igv = vec + d * 128;
    const float* bv = vec + 256 + d * 128;
    const float* pmv = vec + 512 + d * 128;
    float ms = p.mstart[sid * 66 + j];
    if (tid < 128) {
      float inter = bv[tid] + ms;
      float mr = fmaxf(inter, bv[tid] + pmv[tid]);
      mrow[tid] = mr;
      winter[tid] = __expf(inter - mr);
    } else if (tid < 192) {
      nst[tid - 128] = nslot[tid - 128];
    }
    __syncthreads();
    {
      f32x16 acc[2][2];
      auto gA = [&](int kt, int r, int ko) -> uint4 { return *(const uint4*)(Pb + pidx(rb + r, CQ + h * 64 + ko)); };
      auto gB = [&](int kt, int r, int ko) -> uint4 { return *(const uint4*)(Pb + pidx(rb + r, CK + h * 64 + ko)); };
      block_gemm<128, 128, 64, false, false>(acc, gA, gB, 1, sA, sB);
      acc_foreach<128, 128>(acc, [&](int t, int s, float v) { Sl[t * 136 + s] = f2bf(v); });
    }
    __syncthreads();
#pragma unroll 1
    for (int i = 0; i < 8; i++) {
      int idx = tid + 256 * i;
      int t = idx >> 4, s0 = (idx & 15) * 8;
      uint4 u = *(const uint4*)(Sl + t * 136 + s0);
      float rowc = bv[t] - mrow[t];
      float4 b0 = *(const float4*)(bv + s0), b1 = *(const float4*)(bv + s0 + 4);
      float4 g0 = *(const float4*)(igv + s0), g1 = *(const float4*)(igv + s0 + 4);
      float e[8];
      e[0] = lo2f(u.x) * __expf(rowc - b0.x + g0.x); e[1] = hi2f(u.x) * __expf(rowc - b0.y + g0.y);
      e[2] = lo2f(u.y) * __expf(rowc - b0.z + g0.z); e[3] = hi2f(u.y) * __expf(rowc - b0.w + g0.w);
      e[4] = lo2f(u.z) * __expf(rowc - b1.x + g1.x); e[5] = hi2f(u.z) * __expf(rowc - b1.y + g1.y);
      e[6] = lo2f(u.w) * __expf(rowc - b1.z + g1.z); e[7] = hi2f(u.w) * __expf(rowc - b1.w + g1.w);
#pragma unroll
      for (int q = 0; q < 8; q++) {
        int sq = s0 + q;
        bool ok = d ? (sq >= t) : (sq <= t);
        e[q] = ok ? 0.125f * e[q] : 0.f;
      }
      *(uint4*)(Sl + t * 136 + s0) = make_uint4(pack2(e[0], e[1]), pack2(e[2], e[3]), pack2(e[4], e[5]), pack2(e[6], e[7]));
    }
    __syncthreads();
    {
      int t = tid >> 1, hh = tid & 1;
      float rs = 0.f, qn = 0.f;
#pragma unroll
      for (int i = 0; i < 8; i++) {
        uint4 u = *(const uint4*)(Sl + t * 136 + hh * 64 + i * 8);
        rs += lo2f(u.x) + hi2f(u.x) + lo2f(u.y) + hi2f(u.y) + lo2f(u.z) + hi2f(u.z) + lo2f(u.w) + hi2f(u.w);
      }
      const bf* qp = Pb + pidx(rb + t, CQ + h * 64 + hh * 32);
      const float* np_ = nst + hh * 32;
#pragma unroll
      for (int i = 0; i < 4; i++) {
        uint4 u = *(const uint4*)(qp + i * 8);
        qn += lo2f(u.x) * np_[i * 8 + 0] + hi2f(u.x) * np_[i * 8 + 1] + lo2f(u.y) * np_[i * 8 + 2] + hi2f(u.y) * np_[i * 8 + 3] +
              lo2f(u.z) * np_[i * 8 + 4] + hi2f(u.z) * np_[i * 8 + 5] + lo2f(u.w) * np_[i * 8 + 6] + hi2f(u.w) * np_[i * 8 + 7];
      }
      rs += __shfl_xor(rs, 1);
      qn += __shfl_xor(qn, 1);
      if (hh == 0) {
        float den = rs + winter[t] * 0.125f * qn;
        dinv[t] = __builtin_amdgcn_rcpf(fmaxf(fabsf(den), __expf(-mrow[t])));
      }
    }
    __syncthreads();
    {
      auto gA = [&](int kt, int r, int ko) -> uint4 {
        if (kt < 4) return scale8(*(const uint4*)(Sl + r * 136 + kt * 32 + ko), dinv[r]);
        uint4 q = *(const uint4*)(Pb + pidx(rb + r, CQ + h * 64 + (kt - 4) * 32 + ko));
        return scale8(q, winter[r] * 0.125f * dinv[r]);
      };
      auto gB = [&](int kt, int to, int c) -> uint4 {
        if (kt < 4) return *(const uint4*)(Pb + pidx(rb + kt * 32 + to, CV + h * 128 + c));
        return *(const uint4*)(slot + ((kt - 4) * 32 + to) * 128 + c);
      };
      block_gemm<128, 128, 32, false, true, true>(acch, gA, gB, 6, sA, sB, d == 0);
    }
    __syncthreads();
  }
  float* Hs = (float*)smem;
  acc_foreach<128, 128>(acch, [&](int t, int c, float v) { Hs[t * 132 + c] = v; });
  __syncthreads();
  {
    const int t = tid >> 1, hh = tid & 1;
    const float* hrow = Hs + t * 132 + hh * 64;
    float ss = 0.f;
#pragma unroll 4
    for (int i = 0; i < 16; i++) {
      float4 v = *(const float4*)(hrow + i * 4);
      ss += v.x * v.x + v.y * v.y + v.z * v.z + v.w * v.w;
    }
    ss += __shfl_xor(ss, 1);
    const float rstd = rsqrtf(ss * (1.f / 128.f) + EPS);
    const float* gh = p.g_hnorm + l * D + h * 128 + hh * 64;
#pragma unroll 2
    for (int i = 0; i < 8; i++) {
      bf* op = Pb + pidx(rb + t, CO + h * 128 + hh * 64 + i * 8);
      uint4 uo = *(const uint4*)op;
      uint4 uz = *(const uint4*)(Pb + pidx(rb + t, CZA + h * 128 + hh * 64 + i * 8));
      float4 h0 = *(const float4*)(hrow + i * 8), h1 = *(const float4*)(hrow + i * 8 + 4);
      float4 g0 = *(const float4*)(gh + i * 8), g1 = *(const float4*)(gh + i * 8 + 4);
      float y0 = h0.x * rstd * g0.x * sigm(lo2f(uo.x)) * silu(lo2f(uz.x));
      float y1 = h0.y * rstd * g0.y * sigm(hi2f(uo.x)) * silu(hi2f(uz.x));
      float y2 = h0.z * rstd * g0.z * sigm(lo2f(uo.y)) * silu(lo2f(uz.y));
      float y3 = h0.w * rstd * g0.w * sigm(hi2f(uo.y)) * silu(hi2f(uz.y));
      float y4 = h1.x * rstd * g1.x * sigm(lo2f(uo.z)) * silu(lo2f(uz.z));
      float y5 = h1.y * rstd * g1.y * sigm(hi2f(uo.z)) * silu(hi2f(uz.z));
      float y6 = h1.z * rstd * g1.z * sigm(lo2f(uo.w)) * silu(lo2f(uz.w));
      float y7 = h1.w * rstd * g1.w * sigm(hi2f(uo.w)) * silu(hi2f(uz.w));
      *(uint4*)op = make_uint4(pack2(y0, y1), pack2(y2, y3), pack2(y4, y5), pack2(y6, y7));
    }
  }
  __syncthreads();
}

DEV void phase6(const Params& p, int l, unsigned char* smem) {
  bf* sA = (bf*)smem;
  bf* sB = (bf*)(smem + OFF_SB);
  const int bid = obid();
  const int nxb = gridDim.x >> 3, xcd = bid & 7, lb = bid >> 3;
  if (l == 1) {
    bf* sA2 = (bf*)smem;
    bf* sB2 = (bf*)(smem + 40960);
    for (int t = xcd * 64 + lb; t < (xcd + 1) * 64; t += nxb) {
      int m256 = (t >> 6) * 8 + (t & 7), nt = (t >> 3) & 7;
      int rowbase = (m256 >> 5) * TB + 256 + (m256 & 31) * 256;
      const bf* A = p.P;
      const bf* B = p.wt_out + ((size_t)l * D + nt * 128) * 2048;
      f32x16 acc[4][2];
      auto gA = [&](int kt, int r, int ko) -> uint4 {
        int k = kt * 32;
        int col = (kt < 32 ? CO + k : (kt < 48 ? CU + (k - 1024) : CHR + (k - 1536))) + ko;
        return *(const uint4*)(A + pidx(rowbase + r, col));
      };
      auto gB = [&](int kt, int r, int ko) -> uint4 { return *(const uint4*)(B + (unsigned)(r * 2048 + kt * 32 + ko)); };
      block_gemm<256, 128, 32, false, false, true>(acc, gA, gB, 64, sA2, sB2);
      bf* Yt = p.ybuf + (size_t)rowbase * D + nt * 128;
      store_tile_bf16<256>(acc, (bf*)smem, [&](int row) -> bf* { return Yt + (unsigned)(row * D); }, 128);
    }
    return;
  }
  const int nmt = (l == 0) ? 132 : 128;
  const int per = nmt;
  for (int t = xcd * per + lb; t < (xcd + 1) * per; t += nxb) {
    int mtl, nt;
    if (t < 1024) { mtl = (t >> 6) * 8 + (t & 7); nt = (t >> 3) & 7; }
    else { mtl = 128 + ((t - 1024) & 3); nt = (t - 1024) >> 2; }
    int rowbase = (l == 0) ? mtl * 128 : ((mtl >> 6) * TB + 256 + (mtl & 63) * 128);
    const int mt = rowbase >> 7;
    const bf* A = p.P;
    const bf* B = p.wt_out + ((size_t)l * D + nt * 128) * 2048;
    f32x16 acc[2][2];
    auto gA = [&](int kt, int r, int ko) -> uint4 {
      int k = kt * 64;
      int col = (kt < 16 ? CO + k : (kt < 24 ? CU + (k - 1024) : CHR + (k - 1536))) + ko;
      return *(const uint4*)(A + pidx(rowbase + r, col));
    };
    auto gB = [&](int kt, int r, int ko) -> uint4 { return *(const uint4*)(B + (unsigned)(r * 2048 + kt * 64 + ko)); };
    block_gemm<128, 128, 64, false, false, true>(acc, gA, gB, 32, sA, sB);
    bf* Yt = p.ybuf + (size_t)mt * 128 * D + nt * 128;
    store_tile_bf16<128>(acc, (bf*)smem, [&](int row) -> bf* { return Yt + (unsigned)(row * D); }, 128);
  }
}

DEV void phase7(const Params& p, int l, int hf) {
  const int lane = otid() & 63, w = otid() >> 6;
  for (int rl = obid() * 4 + w; rl < HROWS; rl += gridDim.x * 4) {
    int r = hf * HROWS + rl;
    int b = r / TB, j = r % TB;
    const float* xin;
    float* xo;
    int mv;
    if (j < 256) {
      if (l != 0) continue;
      xin = p.ctx + ((size_t)b * 256 + j) * D;
      xo = p.xc1 + ((size_t)b * 256 + j) * D;
      mv = 4;
    } else {
      xin = (l == 0 ? p.x : p.out) + ((size_t)b * 8192 + (j - 256)) * D;
      xo = p.out + ((size_t)b * 8192 + (j - 256)) * D;
      mv = b;
    }
    const float* gt = p.mod + (size_t)(l * 5 + mv) * 3072 + 2048;
    const bf* yp = p.ybuf + (size_t)rl * D;
    float y[16];
    float ss = 0.f;
#pragma unroll
    for (int i = 0; i < 4; i++) {
      uint2 u = *(const uint2*)(yp + lane * 4 + 256 * i);
      y[i * 4 + 0] = lo2f(u.x); y[i * 4 + 1] = hi2f(u.x); y[i * 4 + 2] = lo2f(u.y); y[i * 4 + 3] = hi2f(u.y);
      ss += y[i * 4] * y[i * 4] + y[i * 4 + 1] * y[i * 4 + 1] + y[i * 4 + 2] * y[i * 4 + 2] + y[i * 4 + 3] * y[i * 4 + 3];
    }
#pragma unroll
    for (int off = 32; off; off >>= 1) ss += __shfl_xor(ss, off);
    float rstd = rsqrtf(ss * (1.f / 1024.f) + EPS);
#pragma unroll
    for (int i = 0; i < 4; i++) {
      int col = lane * 4 + 256 * i;
      float4 xv = nt_load4(xin + col);
      float4 g = *(const float4*)(p.g_post + l * D + col);
      float4 gv = *(const float4*)(gt + col);
      float4 o;
      o.x = xv.x + gv.x * (y[i * 4 + 0] * rstd * g.x);
      o.y = xv.y + gv.y * (y[i * 4 + 1] * rstd * g.y);
      o.z = xv.z + gv.z * (y[i * 4 + 2] * rstd * g.z);
      o.w = xv.w + gv.w * (y[i * 4 + 3] * rstd * g.w);
      nt_store4(xo + col, o);
    }
  }
}


#define XB_TMO      128
#define XB_XCNT(j)  (256  + 64 * (j))
#define XB_XSUB(j)  (1280 + 64 * (j))
#define XB_XGEN(j)  (2304 + 64 * (j))
#define XB_TOP      3328
#define XB_TOPGEN   3392
#define XCD_BAR_WORDS 3456
#define XB_SPIN_CAP (1u << 18)
#define LAS __attribute__((address_space(3)))
DEV unsigned xb_ld(unsigned* p) { return __hip_atomic_load(p, __ATOMIC_RELAXED, __HIP_MEMORY_SCOPE_AGENT); }
DEV unsigned xb_add(unsigned* p, unsigned v) { return __hip_atomic_fetch_add(p, v, __ATOMIC_RELAXED, __HIP_MEMORY_SCOPE_AGENT); }
DEV unsigned xb_xcc_id() { return (unsigned)__builtin_amdgcn_s_getreg((3 << 11) | 20) & 0xFu; }
#define XB_SPIN(cond, bar) do { unsigned _sp = 0; while (cond) { __builtin_amdgcn_s_sleep(1); \
    if ((++_sp & 255u) == 0u) { if (xb_ld(&(bar)[XB_TMO])) break; if (_sp > XB_SPIN_CAP) { atomicAdd(&(bar)[XB_TMO], 1u); break; } } } } while (0)
struct XcdBarrier {
  unsigned* bar;
  unsigned x;
  volatile LAS unsigned* st;
};
DEV XcdBarrier xcd_barrier_post(unsigned* bar, volatile LAS unsigned* st) {
  XcdBarrier b;
  b.bar = bar;
  b.x = xb_xcc_id();
  b.st = st;
  if (threadIdx.x == 0) (void)xb_add(&bar[XB_XCNT(b.x)], 1u);
  return b;
}
DEV void xcd_barrier_complete(unsigned* bar, unsigned x, unsigned& nloc, unsigned& nx) {
  const unsigned G = gridDim.x * gridDim.y * gridDim.z;
  unsigned sum, cnt, mine, sp = 0u;
  for (;;) {
    sum = 0u; cnt = 0u; mine = 0u;
#pragma unroll
    for (unsigned j = 0; j < 16; ++j) {
      const unsigned c = xb_ld(&bar[XB_XCNT(j)]);
      sum += c;
      cnt += (c > 0u) ? 1u : 0u;
      mine = (j == x) ? c : mine;
    }
    if (sum == G) break;
    __builtin_amdgcn_s_sleep(1);
    if ((++sp & 255u) == 0u) {
      if (xb_ld(&bar[XB_TMO])) break;
      if (sp > XB_SPIN_CAP) { atomicAdd(&bar[XB_TMO], 1u); break; }
    }
  }
  nloc = mine > 0u ? mine : 1u;
  nx = cnt > 0u ? cnt : 1u;
}
DEV void xcd_barrier(const XcdBarrier& b) {
  asm volatile("s_waitcnt vmcnt(0)" ::: "memory");
  __syncthreads();
  if (threadIdx.x == 0) {
    unsigned* bar = b.bar;
    __builtin_amdgcn_s_waitcnt(0);
    unsigned nloc = b.st[0], nx = b.st[1];
    if (nloc == 0u) {
      xcd_barrier_complete(bar, b.x, nloc, nx);
      b.st[0] = nloc;
      b.st[1] = nx;
    }
    const unsigned old = xb_add(&bar[XB_XSUB(b.x)], 1u);
    const unsigned gen = old / nloc;
    if (old + 1u == (gen + 1u) * nloc) {
      __builtin_amdgcn_fence(__ATOMIC_RELEASE, "agent");
      asm volatile("s_waitcnt vmcnt(0)" ::: "memory");
      const unsigned og = xb_add(&bar[XB_TOP], 1u);
      const unsigned tg = og / nx;
      if (og + 1u == (tg + 1u) * nx) xb_add(&bar[XB_TOPGEN], 1u);
      else XB_SPIN(xb_ld(&bar[XB_TOPGEN]) == tg, bar);
      __builtin_amdgcn_fence(__ATOMIC_ACQUIRE, "agent");
      xb_add(&bar[XB_XGEN(b.x)], 1u);
      asm volatile("s_waitcnt vmcnt(0)" ::: "memory");
    } else {
      XB_SPIN(xb_ld(&bar[XB_XGEN(b.x)]) == gen, bar);
      __builtin_amdgcn_fence(__ATOMIC_ACQUIRE, "agent");
      asm volatile("s_waitcnt vmcnt(0)" ::: "memory");
    }
  }
  __syncthreads();
}

__global__ void __launch_bounds__(256, 2) mk_forward(Params p) {
  extern __shared__ __attribute__((aligned(16))) unsigned char smem[];
  cg::grid_group grid = cg::this_grid();
  volatile LAS unsigned* xst = (volatile LAS unsigned*)(smem + LDS_BYTES - 16);
  if (threadIdx.x == 0) { xst[0] = 0u; xst[1] = 0u; xst[2] = 0u; xst[3] = 0u; }
  __syncthreads();
  XcdBarrier xb = xcd_barrier_post(p.bar, xst);
  phase0a(p, smem);
  if (p.bar == nullptr) grid.sync();
  xcd_barrier(xb);
  phase0b(p, smem);
  phase1(p, 0);
  xcd_barrier(xb);
  for (int l = 0; l < 2; l++) {
    for (int hf = 0; hf < 2; hf++) {
      if (hf == 0) {
        phase2(p, l, 0, smem);
        xcd_barrier(xb);
      }
      phase3(p, l, smem);
      xcd_barrier(xb);
      phase4(p, l, smem);
      xcd_barrier(xb);
      for (int it = obid(); it < (l == 0 ? 1056 : 1024); it += gridDim.x) mlstm_out_item(p, l, it, smem);
      xcd_barrier(xb);
      phase6(p, l, smem);
      xcd_barrier(xb);
      phase7(p, l, hf);
      if (hf == 0) {
        phase2(p, l, 1, smem);
        xcd_barrier(xb);
      }
    }
    if (l == 0) {
      xcd_barrier(xb);
      phase1(p, 1);
      xcd_barrier(xb);
    }
  }
}

extern "C" void kernel_launch(void* const* d_in, const int* in_sizes, int n_in, void* d_out, int out_size, void* d_ws,
                              size_t ws_size, hipStream_t stream) {
  static int grid_blocks = 0;
  if (grid_blocks == 0) {
    int dev = 0, cus = 0, per_cu = 0;
    hipGetDevice(&dev);
    hipDeviceGetAttribute(&cus, hipDeviceAttributeMultiprocessorCount, dev);
    if (hipFuncSetAttribute((const void*)mk_forward, hipFuncAttributeMaxDynamicSharedMemorySize, LDS_BYTES) != hipSuccess) {
      fprintf(stderr, "hipFuncSetAttribute failed\n");
    }
    if (hipOccupancyMaxActiveBlocksPerMultiprocessor(&per_cu, (const void*)mk_forward, 256, LDS_BYTES) != hipSuccess || per_cu < 1) {
      fprintf(stderr, "occupancy query failed (%d)\n", per_cu);
      per_cu = 1;
    }
    (void)hipGetLastError();
    if (per_cu > 2) per_cu = 2;
    grid_blocks = cus * per_cu;
  }
  Params p{};
  p.x = (const float*)d_in[0]; p.c = (const float*)d_in[1]; p.ctx = (const float*)d_in[2]; p.c_ctx = (const float*)d_in[3];
  p.w_mod = (const float*)d_in[4]; p.b_mod = (const float*)d_in[5]; p.g_pre = (const float*)d_in[6];
  p.g_post = (const float*)d_in[7]; p.w_in = (const float*)d_in[8]; p.b_gate = (const float*)d_in[9];
  p.g_hnorm = (const float*)d_in[10]; p.g_sgu = (const float*)d_in[11]; p.w_sp = (const float*)d_in[12];
  p.b_sp = (const float*)d_in[13]; p.w_fno = (const float*)d_in[14]; p.b_fno = (const float*)d_in[15];
  p.w_out = (const float*)d_in[16];
  p.out = (float*)d_out;
  size_t off = 0;
  unsigned char* ws = (unsigned char*)d_ws;
  auto take = [&](size_t bytes) -> void* {
    void* r = ws + off;
    off += (bytes + 255) & ~(size_t)255;
    return r;
  };
  p.wt_in = (bf*)take((size_t)2 * NPW * D * 2);
  p.wt_out = (bf*)take((size_t)2 * D * 2048 * 2);
  p.wsp = (bf*)take((size_t)2 * 4 * 128 * 128 * 2);
  p.m1 = (bf*)take(128 * 128 * 2);
  p.m2 = (bf*)take(128 * 256 * 2);
  p.mctx = (bf*)take(256 * 512 * 2);
  p.hN = (bf*)take((size_t)ROWS * D * 2);
  p.P = (bf*)take((size_t)57 * HROWS * 128 * 2);
  p.abuf = (bf*)take((size_t)2 * 64 * 2 * 128 * 512 * 2);
  p.ybuf = (bf*)take((size_t)HROWS * D * 2);
  p.cbuf = (bf*)take((size_t)2 * 256 * 512 * 2);
  p.mod = (float*)take(2 * 5 * 3072 * 4);
  p.tw = (float*)take(128 * 64 * 8);
  p.Q = (float*)take((size_t)2 * 4 * 128 * 256 * 4);
  p.gates = (float*)take((size_t)HROWS * 32 * 4);
  p.states = (bf*)take((size_t)32 * 66 * 8192 * 2);
  p.nbuf = (float*)take((size_t)32 * 66 * 64 * 4);
  p.scal = (float*)take(32 * 66 * 2 * 4);
  p.mstart = (float*)take(32 * 66 * 4);
  p.xc1 = (float*)take((size_t)1024 * 1024 * 4);
  p.bar = (unsigned*)take((size_t)XCD_BAR_WORDS * 4);
  if (off > ws_size) {
    fprintf(stderr, "workspace too small: need %zu have %zu\n", off, ws_size);
    return;
  }
  if (hipMemsetAsync(p.bar, 0, (size_t)XCD_BAR_WORDS * 4, stream) != hipSuccess) fprintf(stderr, "memset failed\n");
  void* args[] = {&p};
  hipError_t e = hipLaunchCooperativeKernel((const void*)mk_forward, dim3(grid_blocks), dim3(256), args, LDS_BYTES, stream);
  if (e != hipSuccess) fprintf(stderr, "cooperative launch failed: %s (grid %d)\n", hipGetErrorString(e), grid_blocks);
}
```
